# Optimizing an MI355X kernel written in HIP

```python
import math
import jax, jax.numpy as jnp
from jax import lax
import numpy as np

D_MODEL = 1024
BATCH = 8
SEQ = 4096
DEPTH = 2

GRID_W = 64
CTX_LEN = 256
NORM_EPS = 1e-6
N_HEADS = 8
N_KV_HEADS = 2
HEAD_DIM = 128
ATT_WIDTH = N_HEADS * HEAD_DIM
KV_WIDTH = N_KV_HEADS * HEAD_DIM
ROPE_THETA = 10000.0
Q_BLOCK = 128
ATT_SCALE = HEAD_DIM ** -0.5
HY_WIDTH = D_MODEL // 2
HY_ORDER = 2
HY_SHORT = 3
HY_FILTER_HIDDEN = 64
HY_BANDS = 16
HY_PE_DIM = 1 + 2 * HY_BANDS
HY_FAST_DECAY = 0.3
HY_SLOW_DECAY = 1.5
HY_DECAY_TARGET = 1e-2
N_EXPERTS = 64
N_GROUPS = 8
EXPERTS_PER_GROUP = N_EXPERTS // N_GROUPS
TOP_K = 2
EXPERT_DIM = 512
MOE_BLOCK = 256
IN_WIDTH = ATT_WIDTH + 2 * KV_WIDTH + 3 * HY_WIDTH + 2 * D_MODEL
SPLITS = (ATT_WIDTH, ATT_WIDTH + KV_WIDTH, ATT_WIDTH + 2 * KV_WIDTH,
          ATT_WIDTH + 2 * KV_WIDTH + 3 * HY_WIDTH)

kernel_name = 'hybrid_attn_hyena_moe_diffusion_trunk'


def rms_norm(x, w):
    xf = x.astype(jnp.float32)
    y = xf * lax.rsqrt(jnp.mean(xf * xf, axis=-1, keepdims=True) + NORM_EPS)
    return (y * w.astype(jnp.float32)).astype(x.dtype)


def modulate(h, shift, scale):
    return h * (1 + scale) + shift


def head_norm(t, w, n_heads):
    B, L = t.shape[:2]
    return rms_norm(t.reshape(B, L, n_heads, HEAD_DIM), w)


def axial_rope(L):
    rows = L // GRID_W
    row = jnp.broadcast_to(jnp.arange(rows)[:, None], (rows, GRID_W)).reshape(-1).astype(jnp.float32)
    col = jnp.broadcast_to(jnp.arange(GRID_W)[None, :], (rows, GRID_W)).reshape(-1).astype(jnp.float32)
    n = HEAD_DIM // 4
    inv = ROPE_THETA ** (-jnp.arange(n, dtype=jnp.float32) / n)
    ang = jnp.concatenate([row[:, None] * inv, col[:, None] * inv], axis=-1)
    return jnp.cos(ang), jnp.sin(ang)


def apply_rope(x, cos, sin):
    x1, x2 = jnp.split(x, 2, axis=-1)
    c = cos[None, :, None, :].astype(x.dtype)
    s = sin[None, :, None, :].astype(x.dtype)
    return jnp.concatenate([x1 * c - x2 * s, x1 * s + x2 * c], axis=-1)


def gqa_attention(q, k, v, block):
    B, L = q.shape[:2]
    G = N_HEADS // N_KV_HEADS
    nb = L // block
    qb = jnp.moveaxis(q.reshape(B, nb, block, N_KV_HEADS, G, HEAD_DIM), 1, 0)

    def attend(qblk):
        s = jnp.einsum('bqhgd,bkhd->bhgqk', qblk, k).astype(jnp.float32) * ATT_SCALE
        p = jax.nn.softmax(s, axis=-1).astype(v.dtype)
        return jnp.einsum('bhgqk,bkhd->bqhgd', p, v)

    o = lax.map(attend, qb)
    return jnp.moveaxis(o, 0, 1).reshape(B, L, ATT_WIDTH)


def hyena_filters(L, pe_w1, pe_b1, freq1, pe_w2, pe_b2, freq2, pe_w3):
    t01 = jnp.linspace(0.0, 1.0, L, dtype=jnp.float32)[:, None]
    pos = jnp.arange(L, dtype=jnp.float32)[:, None]
    bands = jnp.linspace(1e-4, HY_BANDS - 1, HY_BANDS, dtype=jnp.float32)[None, :]
    f = 2.0 * math.pi * pos * bands / L
    z = jnp.concatenate([t01, jnp.cos(f), -jnp.sin(f)], axis=-1).astype(pe_w1.dtype)
    h = jnp.sin(freq1 * (z @ pe_w1 + pe_b1))
    h = jnp.sin(freq2 * (h @ pe_w2 + pe_b2))
    h = h @ pe_w3
    max_decay = math.log(HY_DECAY_TARGET) / HY_FAST_DECAY
    min_decay = math.log(HY_DECAY_TARGET) / HY_SLOW_DECAY
    deltas = jnp.abs(jnp.linspace(min_decay, max_decay, HY_WIDTH, dtype=jnp.float32))
    window = jnp.exp(-t01 * deltas[None, :]).astype(h.dtype)
    return h.reshape(L, HY_ORDER, 2, HY_WIDTH) * window[:, None, None, :]


def bidir_long_conv(u, h_fwd, h_bwd):
    L, C = h_fwd.shape
    k = jnp.concatenate([h_fwd, jnp.zeros((1, C), h_fwd.dtype), h_bwd[:0:-1]], axis=0).astype(jnp.float32)
    U = jnp.fft.rfft(u.astype(jnp.float32), n=2 * L, axis=1)
    K = jnp.fft.rfft(k, n=2 * L, axis=0)
    y = jnp.fft.irfft(U * K[None], n=2 * L, axis=1)[:, :L]
    return y.astype(u.dtype)


def short_conv(u, w, b):
    up = jnp.pad(u, ((0, 0), (1, 1), (0, 0)))
    return up[:, :-2] * w[0] + up[:, 1:-1] * w[1] + up[:, 2:] * w[2] + b


def hyena_operator(u_proj, filt, conv_w, conv_b, skip):
    u = short_conv(u_proj, conv_w, conv_b)
    x1, x2, v = jnp.split(u, 3, axis=-1)
    z = x1 * (bidir_long_conv(v, filt[:, 0, 0], filt[:, 0, 1]) + skip[0] * v)
    return x2 * (bidir_long_conv(z, filt[:, 1, 0], filt[:, 1, 1]) + skip[1] * z)


def merge_branches(y_att, y_hy, g, w_att_proj, w_hy_proj, w_out):
    g_att, g_hy = jnp.split(jax.nn.sigmoid(g), 2, axis=-1)
    return (g_att * (y_att @ w_att_proj) + g_hy * (y_hy @ w_hy_proj)) @ w_out


def route(h, router_w, router_b):
    T = h.shape[0]
    scores = jax.nn.sigmoid((h @ router_w).astype(jnp.float32))
    biased = (scores + router_b.astype(jnp.float32)).reshape(T, N_GROUPS, EXPERTS_PER_GROUP)
    grp_score = jnp.sum(lax.top_k(biased, 2)[0], axis=-1)
    g_sel = jnp.argmax(grp_score, axis=-1).astype(jnp.int32)
    in_grp = jnp.take_along_axis(biased, g_sel[:, None, None], axis=1)[:, 0]
    _, local = lax.top_k(in_grp, TOP_K)
    idx = g_sel[:, None] * EXPERTS_PER_GROUP + local.astype(jnp.int32)
    w = jnp.take_along_axis(scores, idx, axis=1)
    return idx, w / jnp.sum(w, axis=-1, keepdims=True)


def moe_ffn(h, router_w, router_b, w1, w3, w2):
    T, D = h.shape
    idx, gate = route(h, router_w, router_b)
    A = T * TOP_K
    flat_e = idx.reshape(-1)
    flat_tok = jnp.repeat(jnp.arange(T, dtype=jnp.int32), TOP_K)
    flat_gate = gate.reshape(-1)
    order = jnp.argsort(flat_e)
    e_sorted = flat_e[order]
    counts = jnp.bincount(flat_e, length=N_EXPERTS)
    padded = (counts + MOE_BLOCK - 1) // MOE_BLOCK * MOE_BLOCK
    pad_end = jnp.cumsum(padded)
    pad_start = pad_end - padded
    start = jnp.cumsum(counts) - counts
    dest = pad_start[e_sorted] + (jnp.arange(A, dtype=jnp.int32) - start[e_sorted])
    n_blocks = -(-A // MOE_BLOCK) + N_EXPERTS
    n_slots = n_blocks * MOE_BLOCK
    slot_tok = jnp.full((n_slots,), T, jnp.int32).at[dest].set(flat_tok[order])
    slot_gate = jnp.zeros((n_slots,), jnp.float32).at[dest].set(flat_gate[order])
    block_e = jnp.minimum(jnp.searchsorted(pad_end, jnp.arange(n_blocks) * MOE_BLOCK, side='right'),
                          N_EXPERTS - 1)
    h_pad = jnp.concatenate([h, jnp.zeros((1, D), h.dtype)], axis=0)
    xb = h_pad[slot_tok].reshape(n_blocks, MOE_BLOCK, D)

    def expert_block(args):
        xblk, e = args
        return (jax.nn.silu(xblk @ w1[e]) * (xblk @ w3[e])) @ w2[e]

    yb = lax.map(expert_block, (xb, block_e))
    y = yb.reshape(n_slots, D) * slot_gate[:, None].astype(h.dtype)
    return jnp.zeros((T + 1, D), h.dtype).at[slot_tok].add(y)[:T]


def setup_inputs(seed: int = 0) -> dict:
    key = jax.random.key(seed)
    ks = iter(jax.random.split(key, 32))

    def nrm(shape, scale):
        return jax.random.normal(next(ks), shape, jnp.float32) * scale

    D = D_MODEL
    H = HY_FILTER_HIDDEN
    return {
        'x': nrm((BATCH, SEQ, D), 1.0),
        'c': nrm((BATCH, D), 1.0),
        'ctx': nrm((BATCH, CTX_LEN, D), 1.0),
        'c_ctx': nrm((D,), 1.0),
        'w_ada': nrm((DEPTH, D, 6 * D), D ** -0.5),
        'b_ada': nrm((DEPTH, 6 * D), 0.02),
        'norm1_w': 1.0 + nrm((DEPTH, D), 0.05),
        'norm2_w': 1.0 + nrm((DEPTH, D), 0.05),
        'w_in': nrm((DEPTH, D, IN_WIDTH), D ** -0.5),
        'q_norm_w': 1.0 + nrm((DEPTH, HEAD_DIM), 0.05),
        'k_norm_w': 1.0 + nrm((DEPTH, HEAD_DIM), 0.05),
        'hy_conv_w': nrm((DEPTH, HY_SHORT, 3 * HY_WIDTH), HY_SHORT ** -0.5),
        'hy_conv_b': nrm((DEPTH, 3 * HY_WIDTH), 0.02),
        'hy_pe_w1': nrm((DEPTH, HY_PE_DIM, H), HY_PE_DIM ** -0.5),
        'hy_pe_b1': nrm((DEPTH, H), 0.1),
        'hy_freq1': 1.0 + nrm((DEPTH, H), 0.1),
        'hy_pe_w2': nrm((DEPTH, H, H), H ** -0.5),
        'hy_pe_b2': nrm((DEPTH, H), 0.1),
        'hy_freq2': 1.0 + nrm((DEPTH, H), 0.1),
        'hy_pe_w3': nrm((DEPTH, H, HY_ORDER * 2 * HY_WIDTH), 0.01),
        'hy_skip': nrm((DEPTH, HY_ORDER, HY_WIDTH), 0.5),
        'w_att_proj': nrm((DEPTH, ATT_WIDTH, D), ATT_WIDTH ** -0.5),
        'w_hy_proj': nrm((DEPTH, HY_WIDTH, D), HY_WIDTH ** -0.5),
        'w_out': nrm((DEPTH, D, D), D ** -0.5),
        'router_w': nrm((D, N_EXPERTS), D ** -0.5),
        'router_b': nrm((N_EXPERTS,), 0.01),
        'exp_w1': nrm((DEPTH, N_EXPERTS, D, EXPERT_DIM), D ** -0.5),
        'exp_w3': nrm((DEPTH, N_EXPERTS, D, EXPERT_DIM), D ** -0.5),
        'exp_w2': nrm((DEPTH, N_EXPERTS, EXPERT_DIM, D), EXPERT_DIM ** -0.5),
        'final_norm_w': 1.0 + nrm((D,), 0.05),
    }


def reference(x, c, ctx, c_ctx, w_ada, b_ada, norm1_w, norm2_w, w_in, q_norm_w, k_norm_w,
              hy_conv_w, hy_conv_b, hy_pe_w1, hy_pe_b1, hy_freq1, hy_pe_w2, hy_pe_b2, hy_freq2,
              hy_pe_w3, hy_skip, w_att_proj, w_hy_proj, w_out, router_w, router_b,
              exp_w1, exp_w3, exp_w2, final_norm_w):
    B, S, D = x.shape
    C = ctx.shape[1]
    cos, sin = axial_rope(S)
    for i in range(DEPTH):
        last = i == DEPTH - 1
        mods = jnp.split(jax.nn.silu(c) @ w_ada[i] + b_ada[i], 6, axis=-1)
        sh1, sc1, g1, sh2, sc2, g2 = [m[:, None, :] for m in mods]
        csh1, csc1, cg1, csh2, csc2, cg2 = jnp.split(jax.nn.silu(c_ctx) @ w_ada[i] + b_ada[i], 6, axis=-1)

        hx = modulate(rms_norm(x, norm1_w[i]), sh1, sc1)
        hc = modulate(rms_norm(ctx, norm1_w[i]), csh1, csc1)
        qx, kx, vx, ux, gx = jnp.split(hx @ w_in[i], SPLITS, axis=-1)
        qx = apply_rope(head_norm(qx, q_norm_w[i], N_HEADS), cos, sin)
        kx = apply_rope(head_norm(kx, k_norm_w[i], N_KV_HEADS), cos, sin)
        vx = vx.reshape(B, S, N_KV_HEADS, HEAD_DIM)
        if last:
            kc, vc = jnp.split(hc @ w_in[i][:, ATT_WIDTH:ATT_WIDTH + 2 * KV_WIDTH], 2, axis=-1)
        else:
            qc, kc, vc, uc, gc = jnp.split(hc @ w_in[i], SPLITS, axis=-1)
        kc = head_norm(kc, k_norm_w[i], N_KV_HEADS)
        vc = vc.reshape(B, C, N_KV_HEADS, HEAD_DIM)

        k_all = jnp.concatenate([kx, kc], axis=1)
        v_all = jnp.concatenate([vx, vc], axis=1)
        ya_x = gqa_attention(qx, k_all, v_all, Q_BLOCK)
        filt_x = hyena_filters(S, hy_pe_w1[i], hy_pe_b1[i], hy_freq1[i], hy_pe_w2[i], hy_pe_b2[i],
                               hy_freq2[i], hy_pe_w3[i])
        yh_x = hyena_operator(ux, filt_x, hy_conv_w[i], hy_conv_b[i], hy_skip[i])
        x = x + g1 * merge_branches(ya_x, yh_x, gx, w_att_proj[i], w_hy_proj[i], w_out[i])
        hx2 = modulate(rms_norm(x, norm2_w[i]), sh2, sc2)

        if last:
            f = moe_ffn(hx2.reshape(B * S, D), router_w, router_b, exp_w1[i], exp_w3[i], exp_w2[i])
            x = x + g2 * f.reshape(B, S, D)
        else:
            qc = head_norm(qc, q_norm_w[i], N_HEADS)
            ya_c = gqa_attention(qc, kc, vc, C)
            filt_c = hyena_filters(C, hy_pe_w1[i], hy_pe_b1[i], hy_freq1[i], hy_pe_w2[i], hy_pe_b2[i],
                                   hy_freq2[i], hy_pe_w3[i])
            yh_c = hyena_operator(uc, filt_c, hy_conv_w[i], hy_conv_b[i], hy_skip[i])
            ctx = ctx + cg1 * merge_branches(ya_c, yh_c, gc, w_att_proj[i], w_hy_proj[i], w_out[i])
            hc2 = modulate(rms_norm(ctx, norm2_w[i]), csh2, csc2)
            tokens = jnp.concatenate([hx2.reshape(B * S, D), hc2.reshape(B * C, D)], axis=0)
            f = moe_ffn(tokens, router_w, router_b, exp_w1[i], exp_w3[i], exp_w2[i])
            x = x + g2 * f[:B * S].reshape(B, S, D)
            ctx = ctx + cg2 * f[B * S:].reshape(B, C, D)
    return rms_norm(x, final_norm_w)
```

```cpp
#include <hip/hip_runtime.h>
#include <cstdio>
#include <cstdint>

#ifndef MK_PER_PHASE
#define MK_PER_PHASE 0
#endif

namespace pg8 {
#define PG8_LAS __attribute__((address_space(3)))
typedef unsigned short bf16_t;
typedef short bf16x8 __attribute__((ext_vector_type(8)));
typedef float f32x4 __attribute__((ext_vector_type(4)));
typedef unsigned u32x4 __attribute__((ext_vector_type(4)));
constexpr int BM = 256, BK = 64, HALF = 128, HTB = HALF * BK * 2  , STAGE_BYTES = 8 * HTB, NXCD = 8, WGM = 8;

__host__ __device__ __forceinline__ int lds_byte(int r, int c) { const int st = (r >> 4) * 2 + (c >> 5), rr = r & 15, cc = c & 31, ob = rr * 64 + cc * 2; return st * 1024 + (ob ^ (((ob >> 9) & 1) << 5)); }
__host__ __device__ __forceinline__ void stage_rc(int b, int& R, int& C) { const int st = b / 1024, sb = b % 1024, swz = sb ^ (((sb >> 9) & 1) << 5); R = (st >> 1) * 16 + swz / 64; C = (st & 1) * 32 + (swz % 64) / 2; }
__host__ __device__ __forceinline__ int perm32(int rho) { const int n = rho >> 4, i = rho & 15; return 8 * (i >> 2) + 4 * n + (i & 3); }

struct Unit { int pm, pn; };
struct Gemm { const bf16_t* A; const bf16_t* Bt; int M, N, K; };

struct StaticOrder {
    int nM, nN, nwg, G, c;
    __host__ __device__ void init(int M, int N, int G_, int c_) { nM = M / BM; nN = N / BM; nwg = nM * nN; G = G_; c = c_; }
    __host__ __device__ bool next(int i, Unit& u) const {
        const long L = (long)i * G + c; if (L >= nwg) return false;
        int wgid = (int)L; { const int q = nwg / NXCD, r = nwg % NXCD, xcd = wgid % NXCD, off = wgid / NXCD; wgid = (xcd < r ? xcd * (q + 1) : r * (q + 1) + (xcd - r) * q) + off; }
        const int nig = WGM * nN, gid = wgid / nig, fm = gid * WGM, gsz = (nM - fm) < WGM ? (nM - fm) : WGM;
        u.pm = fm + ((wgid % nig) % gsz); u.pn = (wgid % nig) / gsz; return true;
    }
    __device__ __forceinline__ void a_ready(const Unit&) const {}
    __device__ __forceinline__ void done(const Unit&) const {}
};

__device__ __forceinline__ unsigned cvt_pk_bf16(float lo, float hi) { unsigned r; asm volatile("v_cvt_pk_bf16_f32 %0, %1, %2" : "=v"(r) : "v"(lo), "v"(hi)); return r; }
typedef float f32x2 __attribute__((ext_vector_type(2)));
__device__ __forceinline__ float bf2f(unsigned b) { return __uint_as_float(b << 16); }
__device__ __forceinline__ float sigm(float x) { return 1.f / (1.f + __expf(-x)); }
__device__ __forceinline__ u32x4 pack8(const f32x4& v0, const f32x4& v1) { u32x4 w; w.x = cvt_pk_bf16(v0[0], v0[1]); w.y = cvt_pk_bf16(v0[2], v0[3]); w.z = cvt_pk_bf16(v1[0], v1[1]); w.w = cvt_pk_bf16(v1[2], v1[3]); return w; }
__device__ __forceinline__ void unpack8(const u32x4& w, f32x4& v0, f32x4& v1) {
    v0[0] = bf2f(w.x & 0xffffu); v0[1] = bf2f(w.x >> 16); v0[2] = bf2f(w.y & 0xffffu); v0[3] = bf2f(w.y >> 16);
    v1[0] = bf2f(w.z & 0xffffu); v1[1] = bf2f(w.z >> 16); v1[2] = bf2f(w.w & 0xffffu); v1[3] = bf2f(w.w >> 16); }

struct EpiStoreBf16 {
    static constexpr bool PERM = true, AFTER_DRAIN = false;
    bf16_t* O; int ldc; int pn_mask;
    __device__ __forceinline__ void operator()(const f32x4 (&acc)[2][2][4][2], const Unit& u, int wr, int wc, int fr, int fq) const {
        bf16_t* base = O + (size_t)(u.pm * BM + wr * 64 + fr) * ldc + (u.pn & pn_mask) * BM + wc * 32 + 8 * fq;
#pragma unroll
        for (int ai = 0; ai < 2; ++ai)
#pragma unroll
            for (int m = 0; m < 4; ++m) { bf16_t* rowp = base + (size_t)(ai * HALF + m * 16) * ldc;
#pragma unroll
                for (int bj = 0; bj < 2; ++bj) *(u32x4*)(rowp + bj * HALF) = pack8(acc[ai][bj][m][0], acc[ai][bj][m][1]); }
    }
};
struct EpiQKVG {
    static constexpr bool PERM = true, AFTER_DRAIN = false;
    bf16_t *Q, *KB, *VB, *G;
    __device__ __forceinline__ void operator()(const f32x4 (&acc)[2][2][4][2], const Unit& u, int wr, int wc, int fr, int fq) const {
        const int pm = u.pm, pn = u.pn; bf16_t* base; int ldc; bool act = false;
        if (pn < 4) { base = Q + (size_t)(pm * BM) * 1024 + pn * BM; ldc = 1024; }
        else if (pn < 6) { const int kv0 = pm < 128 ? (pm >> 4) * 4352 + (pm & 15) * 256 : (pm - 128) * 4352 + 4096; base = (pn == 4 ? KB : VB) + (size_t)kv0 * 256; ldc = 256; }
        else { base = G + (size_t)(pm * BM) * 2048 + (pn - 6) * BM; ldc = 2048; act = true; }
        base += (size_t)(wr * 64 + fr) * ldc + wc * 32 + 8 * fq;
#pragma unroll
        for (int ai = 0; ai < 2; ++ai)
#pragma unroll
            for (int m = 0; m < 4; ++m) { bf16_t* rowp = base + (size_t)(ai * HALF + m * 16) * ldc;
#pragma unroll
                for (int bj = 0; bj < 2; ++bj) { f32x4 v0 = acc[ai][bj][m][0], v1 = acc[ai][bj][m][1];
                    if (act) {
#pragma unroll
                        for (int i = 0; i < 4; ++i) { v0[i] = sigm(v0[i]); v1[i] = sigm(v1[i]); } }
                    *(u32x4*)(rowp + bj * HALF) = pack8(v0, v1); } }
    }
};
template <bool ACCUM> struct EpiMerge {
    static constexpr bool PERM = true, AFTER_DRAIN = false;
    bf16_t* MG; const bf16_t* G; int goff;
    __device__ __forceinline__ void operator()(const f32x4 (&acc)[2][2][4][2], const Unit& u, int wr, int wc, int fr, int fq) const {
        const int row0 = u.pm * BM + wr * 64 + fr, col0 = u.pn * BM + wc * 32 + 8 * fq;
#pragma unroll
        for (int ai = 0; ai < 2; ++ai)
#pragma unroll
            for (int m = 0; m < 4; ++m) { const size_t row = (size_t)(row0 + ai * HALF + m * 16);
#pragma unroll
                for (int bj = 0; bj < 2; ++bj) { const int col = col0 + bj * HALF;
                    const u32x4 gw = *(const u32x4*)(G + row * 2048 + goff + col); f32x4 g0, g1; unpack8(gw, g0, g1);
                    f32x4 v0 = acc[ai][bj][m][0] * g0, v1 = acc[ai][bj][m][1] * g1;
                    if (ACCUM) { const u32x4 pw = *(const u32x4*)(MG + row * 1024 + col); f32x4 p0, p1; unpack8(pw, p0, p1); v0 += p0; v1 += p1; }
                    *(u32x4*)(MG + row * 1024 + col) = pack8(v0, v1); } }
    }
};
struct EpiResid {
    static constexpr bool PERM = false, AFTER_DRAIN = false;
    const float* base_lat; const float* base_ctx; float* X; const float* g1;
    __device__ __forceinline__ void operator()(const f32x4 (&acc)[2][2][4][2], const Unit& u, int wr, int wc, int fr, int fq) const {
        const int pm = u.pm, row0 = pm * BM + wr * 64 + fr, col0 = u.pn * BM + wc * 32 + 4 * fq;
        const float* gp = g1 + (size_t)(pm < 128 ? (pm >> 4) : 8) * 6144 + col0;
        const float* bp = pm < 128 ? base_lat + (size_t)row0 * 1024 + col0 : base_ctx + (size_t)(row0 - 32768) * 1024 + col0;
        float* xp = X + (size_t)row0 * 1024 + col0;
        f32x4 gv[2][2];
#pragma unroll
        for (int bj = 0; bj < 2; ++bj)
#pragma unroll
            for (int n = 0; n < 2; ++n) gv[bj][n] = *(const f32x4*)(gp + bj * HALF + n * 16);
#pragma unroll
        for (int ai = 0; ai < 2; ++ai)
#pragma unroll
            for (int m = 0; m < 4; ++m) { const size_t ro = (size_t)(ai * HALF + m * 16) * 1024;
#pragma unroll
                for (int bj = 0; bj < 2; ++bj)
#pragma unroll
                    for (int n = 0; n < 2; ++n) { const f32x4 b = *(const f32x4*)(bp + ro + bj * HALF + n * 16); *(f32x4*)(xp + ro + bj * HALF + n * 16) = b + gv[bj][n] * acc[ai][bj][m][n]; } }
    }
};
struct EpiLogits {
    static constexpr bool PERM = false, AFTER_DRAIN = false;
    float* LOG;
    __device__ __forceinline__ void operator()(const f32x4 (&acc)[2][2][4][2], const Unit& u, int wr, int wc, int fr, int fq) const {
        float* base = LOG + (size_t)(u.pm * BM + wr * 64 + fr) * 128 + wc * 32 + 4 * fq;
#pragma unroll
        for (int ai = 0; ai < 2; ++ai)
#pragma unroll
            for (int m = 0; m < 4; ++m)
#pragma unroll
                for (int n = 0; n < 2; ++n) *(f32x4*)(base + (size_t)(ai * HALF + m * 16) * 128 + n * 16) = acc[ai][0][m][n];
    }
};
struct EpiSwiGLU {
    static constexpr bool PERM = true, AFTER_DRAIN = false;
    bf16_t* H;
    __device__ __forceinline__ void operator()(const f32x4 (&acc)[2][2][4][2], const Unit& u, int wr, int wc, int fr, int fq) const {
        bf16_t* base = H + (size_t)(u.pm * BM + wr * 64 + fr) * 512 + (u.pn & 3) * 128 + wc * 32 + 8 * fq;
#pragma unroll
        for (int ai = 0; ai < 2; ++ai)
#pragma unroll
            for (int m = 0; m < 4; ++m) { f32x4 v0, v1;
#pragma unroll
                for (int i = 0; i < 4; ++i) { const float a0 = acc[ai][0][m][0][i], a1 = acc[ai][0][m][1][i];
                    v0[i] = a0 * sigm(a0) * acc[ai][1][m][0][i]; v1[i] = a1 * sigm(a1) * acc[ai][1][m][1][i]; }
                *(u32x4*)(base + (size_t)(ai * HALF + m * 16) * 512) = pack8(v0, v1); }
    }
};
struct MoeOrder {
    int nunits, G, c; const int* blk_e;
    __device__ __forceinline__ void init(int nblk, const int* be, int G_, int c_) { nunits = nblk * 4; blk_e = be; G = G_; c = c_; }
    __device__ __forceinline__ bool next(int i, Unit& u) const { const int L = i * G + c; if (L >= nunits) return false; u.pm = L >> 2; u.pn = blk_e[u.pm] * 4 + (L & 3); return true; }
    __device__ __forceinline__ void a_ready(const Unit&) const {}
    __device__ __forceinline__ void done(const Unit&) const {}
};

template <class Epi, class Sched, bool ALIGN_EPI = false, bool SP2 = false>
__device__ __forceinline__ void gemm_phase(PG8_LAS unsigned char* lds, const Gemm g, const Sched& S, const Epi& E) {
    int tid = threadIdx.x; asm volatile("" : "+v"(tid));
    const int wid = __builtin_amdgcn_readfirstlane(tid >> 6), lane = tid & 63, wr = wid >> 2, wc = wid & 3, fr = lane & 15, fq = lane >> 4;
    const int K = g.K, nt = K / BK;
    unsigned voffA[2], voffB[2];
#pragma unroll
    for (int i = 0; i < 2; ++i) { int R, C; stage_rc(tid * 16 + i * 8192, R, C); const int Rb = Epi::PERM ? ((R & ~31) + perm32(R & 31)) : R;
        voffA[i] = (unsigned)(R * K + C) * 2u; voffB[i] = (unsigned)(Rb * K + C) * 2u; }
    const size_t kstep = (size_t)(BK * 2);
    const size_t hstep = (size_t)HALF * K * 2;
    const size_t tstep = 2 * hstep;
    const unsigned ldsw = (unsigned)wid * 1024u;
    const int aoff = lds_byte(wr * 64 + fr, fq * 8), boff = lds_byte(wc * 32 + fr, fq * 8);
#define PG8_SA(b, h) (((b) * 2 + (h)) * HTB)
#define PG8_SB(b, h) ((4 + (b) * 2 + (h)) * HTB)
#define PG8_STAGE(bufoff, gbase, voff) do { _Pragma("unroll") for (int _i = 0; _i < 2; ++_i) \
        __builtin_amdgcn_global_load_lds((const unsigned*)((const char*)(gbase) + (voff)[_i]), (PG8_LAS unsigned*)(lds + (bufoff) + ldsw + _i * 8192), 16, 0, 0); } while (0)
#define PG8_LDA(dst, b, h) do { _Pragma("unroll") for (int m = 0; m < 4; ++m) _Pragma("unroll") for (int k = 0; k < 2; ++k) dst[m][k] = *(const PG8_LAS bf16x8*)(lds + PG8_SA(b, h) + aoff + m * 2048 + k * 1024); } while (0)
#define PG8_LDB(dst, b, h) do { _Pragma("unroll") for (int n = 0; n < 2; ++n) _Pragma("unroll") for (int k = 0; k < 2; ++k) dst[n][k] = *(const PG8_LAS bf16x8*)(lds + PG8_SB(b, h) + boff + n * 2048 + k * 1024); } while (0)
#define PG8_MMA(ai, bj, At, Bt) do { __builtin_amdgcn_s_setprio(1); _Pragma("unroll") for (int m = 0; m < 4; ++m) _Pragma("unroll") for (int n = 0; n < 2; ++n) _Pragma("unroll") for (int k = 0; k < 2; ++k) \
        acc[ai][bj][m][n] = __builtin_amdgcn_mfma_f32_16x16x32_bf16(Bt[n][k], At[m][k], acc[ai][bj][m][n], 0, 0, 0); __builtin_amdgcn_s_setprio(0); } while (0)
#define PG8_WAIT_V(n) asm volatile("s_waitcnt vmcnt(" #n ")" ::: "memory")
#define PG8_WAIT_L(n) asm volatile("s_waitcnt lgkmcnt(" #n ")" ::: "memory")
#define PG8_BAR __builtin_amdgcn_s_barrier()
#define PG8_SCHED __builtin_amdgcn_sched_barrier(0)
    Unit cur, nxt; int ui = 0;
    if (!S.next(0, cur)) return;
    f32x4 acc[2][2][4][2];
#pragma unroll
    for (int a = 0; a < 2; ++a)
#pragma unroll
        for (int b = 0; b < 2; ++b)
#pragma unroll
            for (int m = 0; m < 4; ++m)
#pragma unroll
                for (int n = 0; n < 2; ++n) acc[a][b][m][n] = (f32x4){0.f, 0.f, 0.f, 0.f};
    bf16x8 At[4][2], B0[2][2], B1[2][2];
    const char* cA = (const char*)g.A + (size_t)cur.pm * tstep; const char* cB = (const char*)g.Bt + (size_t)cur.pn * tstep;
    S.a_ready(cur);
    if constexpr (SP2) {
        PG8_STAGE(PG8_SB(0, 0), cB, voffB); PG8_STAGE(PG8_SB(0, 1), cB + hstep, voffB); PG8_STAGE(PG8_SA(0, 0), cA, voffA); PG8_STAGE(PG8_SA(0, 1), cA + hstep, voffA);
        if (wr == 1) PG8_BAR;
        PG8_WAIT_V(2); PG8_BAR;
        PG8_STAGE(PG8_SB(1, 0), cB + kstep, voffB); PG8_STAGE(PG8_SA(1, 0), cA + kstep, voffA); PG8_STAGE(PG8_SB(1, 1), cB + hstep + kstep, voffB);
        PG8_WAIT_V(6); PG8_BAR;
    } else {
        PG8_STAGE(PG8_SB(0, 0), cB, voffB); PG8_STAGE(PG8_SA(0, 0), cA, voffA); PG8_STAGE(PG8_SB(0, 1), cB + hstep, voffB); PG8_STAGE(PG8_SA(0, 1), cA + hstep, voffA);
        if (wr == 1) PG8_BAR;
        PG8_WAIT_V(4); PG8_BAR;
        PG8_STAGE(PG8_SB(1, 0), cB + kstep, voffB); PG8_STAGE(PG8_SA(1, 0), cA + kstep, voffA); PG8_STAGE(PG8_SB(1, 1), cB + hstep + kstep, voffB);
        PG8_WAIT_V(6); PG8_BAR;
    }
    for (;;) {
        const bool has_next = S.next(ui + 1, nxt);
        const char* nA = has_next ? (const char*)g.A + (size_t)nxt.pm * tstep : cA; const char* nB = has_next ? (const char*)g.Bt + (size_t)nxt.pn * tstep : cB;
        for (int t = 0; t < nt; t += 2) {
            const bool last = (t == nt - 2);
            const char* a1 = cA + (size_t)(t + 1) * kstep;
            const char* a2 = last ? nA : cA + (size_t)(t + 2) * kstep; const char* b2 = last ? nB : cB + (size_t)(t + 2) * kstep;
            const char* a3 = a2 + kstep; const char* b3 = b2 + kstep;
            if (last && has_next) S.a_ready(nxt);
            if constexpr (SP2) {
            PG8_LDB(B0, 0, 0); PG8_LDB(B1, 0, 1); PG8_SCHED; PG8_LDA(At, 0, 0); PG8_STAGE(PG8_SA(1, 1), a1 + hstep, voffA);
            PG8_WAIT_V(8); PG8_WAIT_L(0); PG8_BAR; PG8_MMA(0, 0, At, B0); PG8_MMA(0, 1, At, B1); PG8_BAR; PG8_SCHED;
            PG8_LDA(At, 0, 1); PG8_STAGE(PG8_SB(0, 0), b2, voffB); PG8_STAGE(PG8_SB(0, 1), b2 + hstep, voffB); PG8_STAGE(PG8_SA(0, 0), a2, voffA);
            PG8_WAIT_V(8); PG8_WAIT_L(0); PG8_BAR; PG8_MMA(1, 0, At, B0); PG8_MMA(1, 1, At, B1); PG8_BAR; PG8_SCHED;
            PG8_LDB(B0, 1, 0); PG8_LDB(B1, 1, 1); PG8_SCHED; PG8_LDA(At, 1, 0); PG8_STAGE(PG8_SA(0, 1), a2 + hstep, voffA);
            PG8_WAIT_V(8); PG8_WAIT_L(0); PG8_BAR; PG8_MMA(0, 0, At, B0); PG8_MMA(0, 1, At, B1); PG8_BAR; PG8_SCHED;
            PG8_LDA(At, 1, 1); PG8_STAGE(PG8_SB(1, 0), b3, voffB); PG8_STAGE(PG8_SB(1, 1), b3 + hstep, voffB); PG8_STAGE(PG8_SA(1, 0), a3, voffA);
            PG8_WAIT_V(8); PG8_WAIT_L(0); PG8_BAR; PG8_MMA(1, 0, At, B0); PG8_MMA(1, 1, At, B1); PG8_BAR; PG8_SCHED;
            } else {
            PG8_LDB(B0, 0, 0); PG8_SCHED; PG8_LDA(At, 0, 0); PG8_STAGE(PG8_SA(1, 1), a1 + hstep, voffA);
            PG8_WAIT_L(8); PG8_BAR; PG8_WAIT_L(0); PG8_MMA(0, 0, At, B0); PG8_BAR; PG8_SCHED;
            PG8_LDB(B1, 0, 1); PG8_STAGE(PG8_SB(0, 0), b2, voffB);
            PG8_BAR; PG8_WAIT_L(0); PG8_MMA(0, 1, At, B1); PG8_BAR;
            PG8_LDA(At, 0, 1); PG8_STAGE(PG8_SA(0, 0), a2, voffA);
            PG8_BAR; PG8_WAIT_L(0); PG8_MMA(1, 0, At, B0); PG8_BAR; PG8_SCHED;
            PG8_STAGE(PG8_SB(0, 1), b2 + hstep, voffB);
            PG8_WAIT_V(6); PG8_BAR; PG8_MMA(1, 1, At, B1); PG8_BAR;
            PG8_LDB(B0, 1, 0); PG8_SCHED; PG8_LDA(At, 1, 0); PG8_STAGE(PG8_SA(0, 1), a2 + hstep, voffA);
            PG8_WAIT_L(8); PG8_BAR; PG8_WAIT_L(0); PG8_MMA(0, 0, At, B0); PG8_BAR; PG8_SCHED;
            PG8_LDB(B1, 1, 1); PG8_STAGE(PG8_SB(1, 0), b3, voffB);
            PG8_BAR; PG8_WAIT_L(0); PG8_MMA(0, 1, At, B1); PG8_BAR;
            PG8_LDA(At, 1, 1); PG8_STAGE(PG8_SA(1, 0), a3, voffA);
            PG8_BAR; PG8_WAIT_L(0); PG8_MMA(1, 0, At, B0); PG8_BAR; PG8_SCHED;
            PG8_STAGE(PG8_SB(1, 1), b3 + hstep, voffB);
            PG8_WAIT_V(6); PG8_BAR; PG8_MMA(1, 1, At, B1); PG8_BAR;
            }
        }
        if constexpr (ALIGN_EPI) { if (wr == 0) PG8_BAR; }
        if constexpr (!Epi::AFTER_DRAIN) { E(acc, cur, wr, wc, fr, fq); S.done(cur); }
        if (!has_next) break;
#pragma unroll
        for (int a = 0; a < 2; ++a)
#pragma unroll
            for (int b = 0; b < 2; ++b)
#pragma unroll
                for (int m = 0; m < 4; ++m)
#pragma unroll
                    for (int n = 0; n < 2; ++n) acc[a][b][m][n] = (f32x4){0.f, 0.f, 0.f, 0.f};
        cur = nxt; cA = nA; cB = nB; ++ui;
        if constexpr (ALIGN_EPI) { if (wr == 1) PG8_BAR; }
    }
    PG8_WAIT_V(0);
    if constexpr (!ALIGN_EPI) { if (wr == 0) PG8_BAR; }
    PG8_BAR;
    if constexpr (Epi::AFTER_DRAIN) { E.fused(acc, cur, wr, wc, fr, fq, lds, wid, lane); S.done(cur); }
#undef PG8_SA
#undef PG8_SB
#undef PG8_STAGE
#undef PG8_LDA
#undef PG8_LDB
#undef PG8_MMA
#undef PG8_WAIT_V
#undef PG8_WAIT_L
#undef PG8_BAR
#undef PG8_SCHED
}
}

namespace attn {
constexpr int D = 128, NW = 8, QBLK = 32, KVBLK = 64;
constexpr float SCALE = 0.088388347648318440f;
constexpr float THR = 8.f;
constexpr int LDQ = 1024, LDK = 256, LDO = 1024;
constexpr size_t SHM_V = KVBLK * D * 2, SHM_K = KVBLK * D * 2, SHM_ATTN = 2 * SHM_V + 2 * SHM_K + NW * 64 * 4;
typedef unsigned short bf16;
using bf16x8 = __attribute__((ext_vector_type(8))) short;
using s16x4  = __attribute__((ext_vector_type(4))) short;
using f32x16 = __attribute__((ext_vector_type(16))) float;
using u32x4  = __attribute__((ext_vector_type(4))) unsigned;
#define KSWZ(row, colB) ((row) * 256 + ((colB) ^ (((row) & 7) << 4)))
#define SBAR() __builtin_amdgcn_sched_barrier(0)
__device__ __forceinline__ int crow(int r, int hi) { return (r & 3) + 8 * (r >> 2) + 4 * hi; }
__device__ __forceinline__ unsigned cvtpk(float lo, float hi) { unsigned r; asm volatile("v_cvt_pk_bf16_f32 %0, %1, %2" : "=v"(r) : "v"(lo), "v"(hi)); return r; }
__device__ __forceinline__ void partialSM(f32x16& p0, f32x16& p1, float& m_reg, float& mn, float& alpha) {
  constexpr float C = SCALE * 1.4426950408889634f;
  float pmax = p0[0]; for (int r = 1; r < 16; ++r) pmax = fmaxf(pmax, p0[r]); for (int r = 0; r < 16; ++r) pmax = fmaxf(pmax, p1[r]);
  { auto rr = __builtin_amdgcn_permlane32_swap(__float_as_uint(pmax), __float_as_uint(pmax), false, false);
    pmax = fmaxf(__uint_as_float(rr[0]), __uint_as_float(rr[1])); }
  if (__builtin_expect(__all(pmax - m_reg <= THR / SCALE), 1)) { mn = m_reg; alpha = 1.f; }
  else { mn = fmaxf(m_reg, pmax); alpha = __builtin_amdgcn_exp2f((m_reg - mn) * C); m_reg = mn; }
  float mnC = -mn * C;
  for (int r = 0; r < 16; ++r) p0[r] = fmaf(p0[r], C, mnC); for (int r = 0; r < 16; ++r) p1[r] = fmaf(p1[r], C, mnC);
  for (int r = 0; r < 16; ++r) p0[r] = __builtin_amdgcn_exp2f(p0[r]);
}
__device__ __forceinline__ void finishSM(f32x16& p0, f32x16& p1, float alpha, float& l_reg, bf16x8& pa0, bf16x8& pa1, bf16x8& pa2, bf16x8& pa3) {
  for (int r = 0; r < 16; ++r) p1[r] = __builtin_amdgcn_exp2f(p1[r]);
  float ps = 0; for (int r = 0; r < 16; ++r) ps += p0[r]; for (int r = 0; r < 16; ++r) ps += p1[r];
  { auto rr = __builtin_amdgcn_permlane32_swap(__float_as_uint(ps), __float_as_uint(ps), false, false);
    ps = __uint_as_float(rr[0]) + __uint_as_float(rr[1]); }
  l_reg = l_reg * alpha + ps;
#define PK4(P, BASE, OUT) do { unsigned a0 = cvtpk(P[BASE + 0], P[BASE + 1]), a1 = cvtpk(P[BASE + 2], P[BASE + 3]);   \
    unsigned b0 = cvtpk(P[BASE + 4], P[BASE + 5]), b1 = cvtpk(P[BASE + 6], P[BASE + 7]);                              \
    auto r0 = __builtin_amdgcn_permlane32_swap(a0, b0, false, false); auto r1 = __builtin_amdgcn_permlane32_swap(a1, b1, false, false); \
    u32x4 w = {r0[0], r1[0], r0[1], r1[1]}; OUT = *reinterpret_cast<bf16x8*>(&w); } while (0)
  PK4(p0, 0, pa0); PK4(p0, 8, pa1); PK4(p1, 0, pa2); PK4(p1, 8, pa3);
#undef PK4
}
__device__ __forceinline__ void qkt(f32x16& p0, f32x16& p1, const bf16* Ks, const bf16x8* qr, int r32, int hi) {
  p0 = f32x16{}; p1 = f32x16{};
  for (int d0 = 0; d0 < 8; ++d0) { int cb = (d0 * 16 + hi * 8) * 2;
    bf16x8 b0 = *reinterpret_cast<const bf16x8*>((const char*)Ks + KSWZ(r32, cb));
    bf16x8 b1 = *reinterpret_cast<const bf16x8*>((const char*)Ks + KSWZ(32 + r32, cb));
    p0 = __builtin_amdgcn_mfma_f32_32x32x16_bf16(b0, qr[d0], p0, 0, 0, 0);
    p1 = __builtin_amdgcn_mfma_f32_32x32x16_bf16(b1, qr[d0], p1, 0, 0, 0); }
}
__device__ __forceinline__ int v_st(int k, int c) { const int kk = (k & ~0xC) | ((k & 4) << 1) | ((k & 8) >> 1); return ((kk >> 3) * 4 + (c >> 5)) * 512 + ((kk & 7) * 32 + (c & 31)) * 2; }
__device__ __forceinline__ int v_rd_base(int lane) { return ((lane & 3) << 3) | (((lane >> 2) & 3) << 6) | (((lane >> 4) & 1) << 5) | (((lane >> 5) & 1) << 8); }
constexpr int v_rd_off(int d0, int ks, int half) { return d0 * 512 + ks * 4096 + half * 2048; }
template <int OFF> __device__ __forceinline__ s16x4 tr_read(int vb) {
  s16x4 r; asm volatile("ds_read_b64_tr_b16 %0, %1 offset:%2" : "=&v"(r) : "v"(vb), "i"(OFF) : "memory"); return r;
}
template <int D0> __device__ __forceinline__ void pv_one(f32x16& od, int vb, bf16x8 pa0, bf16x8 pa1, bf16x8 pa2, bf16x8 pa3) {
  const s16x4 l0 = tr_read<v_rd_off(D0, 0, 0)>(vb), h0 = tr_read<v_rd_off(D0, 0, 1)>(vb), l1 = tr_read<v_rd_off(D0, 1, 0)>(vb), h1 = tr_read<v_rd_off(D0, 1, 1)>(vb);
  const s16x4 l2 = tr_read<v_rd_off(D0, 2, 0)>(vb), h2 = tr_read<v_rd_off(D0, 2, 1)>(vb), l3 = tr_read<v_rd_off(D0, 3, 0)>(vb), h3 = tr_read<v_rd_off(D0, 3, 1)>(vb);
  asm volatile("s_waitcnt lgkmcnt(0)" ::: "memory"); SBAR();
#define PK(L, H) (bf16x8){L[0], L[1], L[2], L[3], H[0], H[1], H[2], H[3]}
  od = __builtin_amdgcn_mfma_f32_32x32x16_bf16(pa0, PK(l0, h0), od, 0, 0, 0);
  od = __builtin_amdgcn_mfma_f32_32x32x16_bf16(pa1, PK(l1, h1), od, 0, 0, 0);
  od = __builtin_amdgcn_mfma_f32_32x32x16_bf16(pa2, PK(l2, h2), od, 0, 0, 0);
  od = __builtin_amdgcn_mfma_f32_32x32x16_bf16(pa3, PK(l3, h3), od, 0, 0, 0);
#undef PK
}
__device__ __forceinline__ void pv_d0(f32x16* o, int vb, bf16x8 pa0, bf16x8 pa1, bf16x8 pa2, bf16x8 pa3) {
  pv_one<0>(o[0], vb, pa0, pa1, pa2, pa3); pv_one<1>(o[1], vb, pa0, pa1, pa2, pa3); pv_one<2>(o[2], vb, pa0, pa1, pa2, pa3); pv_one<3>(o[3], vb, pa0, pa1, pa2, pa3);
}
__device__ __forceinline__ void attn_dense_body(bf16* __restrict__ Qb, const bf16* __restrict__ Kh, const bf16* __restrict__ Vh, int seq, char* lds,
                                                const float* __restrict__ qnw, const float2* __restrict__ rope, int pos0) {
  int tid = threadIdx.x; asm volatile("" : "+v"(tid));
  const int wid = tid >> 6, lane = tid & 63, r32 = lane & 31, hi = lane >> 5;
  bf16* V_lds = (bf16*)lds; bf16* K_lds = (bf16*)(lds + 2 * SHM_V);
  float* ws = (float*)(lds + 2 * SHM_V + 2 * SHM_K) + wid * 64; float* li_l = ws; float* al_l = ws + 32;
  float m_reg = -1e30f, l_reg = 0; f32x16 o[4] = {}; bf16x8 qr[8];
  bf16* Qw = Qb + (long)(wid * QBLK + r32) * LDQ + hi * 8;
  {
    u32x4 raw[8]; float ss = 0.f;
#pragma unroll
    for (int d0 = 0; d0 < 8; ++d0) { raw[d0] = *reinterpret_cast<const u32x4*>(Qw + d0 * 16);
#pragma unroll
      for (int i = 0; i < 4; ++i) { const float a = __uint_as_float(raw[d0][i] << 16), b = __uint_as_float(raw[d0][i] & 0xffff0000u); ss += a * a + b * b; } }
    ss += __shfl_xor(ss, 32);
    const float rstd = rsqrtf(ss * (1.f / 128.f) + 1e-6f);
    const int pos = pos0 + wid * QBLK + r32;
#pragma unroll
    for (int d0 = 0; d0 < 4; ++d0) {
      float fa[8], fb[8];
      const float* wa = qnw + d0 * 16 + hi * 8; const float* wb = wa + 64;
#pragma unroll
      for (int i = 0; i < 4; ++i) { fa[2 * i] = __uint_as_float(raw[d0][i] << 16) * rstd * wa[2 * i]; fa[2 * i + 1] = __uint_as_float(raw[d0][i] & 0xffff0000u) * rstd * wa[2 * i + 1];
        fb[2 * i] = __uint_as_float(raw[d0 + 4][i] << 16) * rstd * wb[2 * i]; fb[2 * i + 1] = __uint_as_float(raw[d0 + 4][i] & 0xffff0000u) * rstd * wb[2 * i + 1]; }
      if (rope) { const int j0 = d0 * 16 + hi * 8;
        const float2* tp = (d0 < 2) ? rope + (pos >> 6) * 32 + j0 : rope + (pos & 63) * 32 + (j0 - 32);
#pragma unroll
        for (int i = 0; i < 8; ++i) { const float2 cs = tp[i]; const float a = fa[i], b = fb[i]; fa[i] = a * cs.x - b * cs.y; fb[i] = a * cs.y + b * cs.x; } }
      { u32x4 w = {cvtpk(fa[0], fa[1]), cvtpk(fa[2], fa[3]), cvtpk(fa[4], fa[5]), cvtpk(fa[6], fa[7])}; qr[d0] = *reinterpret_cast<bf16x8*>(&w); }
      { u32x4 w = {cvtpk(fb[0], fb[1]), cvtpk(fb[2], fb[3]), cvtpk(fb[4], fb[5]), cvtpk(fb[6], fb[7])}; qr[d0 + 4] = *reinterpret_cast<bf16x8*>(&w); }
    }
  }
  const int sr = tid >> 4, sc = (tid & 15) * 8, vst0 = v_st(sr, sc), vst1 = v_st(32 + sr, sc);
  const int vb0 = (int)(uintptr_t)V_lds + v_rd_base(lane);
  struct { bf16x8 vs0, vs1, ks0, ks1; } sr_[2];
#define LD8(p) (*reinterpret_cast<const bf16x8*>(p))
#define SLOAD(i, k0) do { sr_[i].vs0 = LD8(&Vh[(long)((k0) + sr) * LDK + sc]); sr_[i].vs1 = LD8(&Vh[(long)((k0) + 32 + sr) * LDK + sc]); \
    sr_[i].ks0 = LD8(&Kh[(long)((k0) + sr) * LDK + sc]); sr_[i].ks1 = LD8(&Kh[(long)((k0) + 32 + sr) * LDK + sc]); } while (0)
#define SWRITE(b, i) do { *(bf16x8*)((char*)V_lds + (b) * SHM_V + vst0) = sr_[i].vs0;          \
    *(bf16x8*)((char*)V_lds + (b) * SHM_V + vst1) = sr_[i].vs1; int kc = sc * 2;               \
    *(bf16x8*)((char*)K_lds + (b) * SHM_K + KSWZ(sr, kc)) = sr_[i].ks0;                       \
    *(bf16x8*)((char*)K_lds + (b) * SHM_K + KSWZ(32 + sr, kc)) = sr_[i].ks1; } while (0)
#define SWAIT() asm volatile("s_waitcnt vmcnt(4)" ::: "memory")
#define RESC(a) do { if (__any((a) < 1.f)) { if (hi == 0) al_l[r32] = (a); asm volatile("s_waitcnt lgkmcnt(0)" ::: "memory"); \
    for (int d = 0; d < 4; ++d) for (int r = 0; r < 16; ++r) o[d][r] *= al_l[crow(r, hi)]; } } while (0)
  f32x16 pA0, pA1, pB0, pB1; float mnA, mnB, alA, alB; bf16x8 pa0, pa1, pa2, pa3; const int NT = seq / KVBLK;
  constexpr int SE = 0, SO = 1;
  SLOAD(SE, 0); asm volatile("s_waitcnt vmcnt(0)" ::: "memory"); SWRITE(0, SE); __syncthreads();
  qkt(pA0, pA1, K_lds, qr, r32, hi); partialSM(pA0, pA1, m_reg, mnA, alA);
  SLOAD(SO, KVBLK); if (2 < NT) SLOAD(SE, 2 * KVBLK);
  SWAIT(); SWRITE(1, SO); __syncthreads();
  for (int j = 1; j + 1 < NT; j += 2) {
    SBAR(); qkt(pB0, pB1, (bf16*)((char*)K_lds + SHM_K), qr, r32, hi);
    finishSM(pA0, pA1, alA, l_reg, pa0, pa1, pa2, pa3); SBAR();
    SLOAD(SO, (j + 2) * KVBLK); SBAR();
    pv_d0(o, vb0, pa0, pa1, pa2, pa3); partialSM(pB0, pB1, m_reg, mnB, alB);
    __syncthreads(); SWAIT(); SWRITE(0, SE);
    RESC(alB); __syncthreads();
    SBAR(); qkt(pA0, pA1, K_lds, qr, r32, hi);
    finishSM(pB0, pB1, alB, l_reg, pa0, pa1, pa2, pa3); SBAR();
    if (j + 3 < NT) SLOAD(SE, (j + 3) * KVBLK); SBAR();
    pv_d0(o, vb0 + (int)SHM_V, pa0, pa1, pa2, pa3); partialSM(pA0, pA1, m_reg, mnA, alA);
    __syncthreads(); SWAIT(); SWRITE(1, SO);
    RESC(alA); __syncthreads();
  }
  SBAR(); qkt(pB0, pB1, (bf16*)((char*)K_lds + SHM_K), qr, r32, hi);
  finishSM(pA0, pA1, alA, l_reg, pa0, pa1, pa2, pa3); SBAR();
  pv_d0(o, vb0, pa0, pa1, pa2, pa3); partialSM(pB0, pB1, m_reg, mnB, alB);
  __syncthreads(); RESC(alB);
  finishSM(pB0, pB1, alB, l_reg, pa0, pa1, pa2, pa3); SBAR();
  pv_d0(o, vb0 + (int)SHM_V, pa0, pa1, pa2, pa3);
  if (hi == 0) li_l[r32] = l_reg; asm volatile("s_waitcnt lgkmcnt(0)" ::: "memory");
  float rli[16];
#pragma unroll
  for (int r = 0; r < 16; ++r) rli[r] = __builtin_amdgcn_rcpf(li_l[crow(r, hi)]);
  bf16* Ow = Qb + (long)(wid * QBLK) * LDO;
#pragma unroll
  for (int r = 0; r < 16; ++r) { int orow = crow(r, hi);
    for (int d0 = 0; d0 < 4; ++d0) Ow[(long)orow * LDO + d0 * 32 + r32] = (bf16)(cvtpk(o[d0][r] * rli[r], 0.f) & 0xffffu); }
  __syncthreads();
#undef LD8
#undef SLOAD
#undef SWRITE
#undef SWAIT
#undef RESC
}
#undef KSWZ
#undef SBAR
}

constexpr int NWAVES = 8, NTHR = 512;
constexpr int NB = 8, SEQ = 4096, DM = 1024, CL = 256, T_LAT = NB * SEQ, T_CTX = NB * CL, R_ALL = T_LAT + T_CTX;
constexpr int SKV = SEQ + CL;
constexpr int NH = 8, NKV = 2, HD = 128;
constexpr int HYW = 512, NE = 64, EDIM = 512;
constexpr int INW = 5120, NA_COLS = 3584, NU_COLS = 1536;
constexpr int NSLOT_MAX = 86016;
constexpr float EPS = 1e-6f;
enum { I_X = 0, I_C, I_CTX, I_CCTX, I_WADA, I_BADA, I_N1W, I_N2W, I_WIN, I_QNW, I_KNW, I_HCW, I_HCB, I_PW1, I_PB1, I_PF1, I_PW2, I_PB2, I_PF2, I_PW3, I_SKIP,
       I_WAP, I_WHP, I_WOUT, I_RW, I_RB, I_EW1, I_EW3, I_EW2, I_FNW, N_IN };
constexpr size_t MiB = 1u << 20;
constexpr size_t WS_CTL = 0, CTL_ZERO_BYTES = 1 * MiB;
constexpr size_t WS_MODP = 1 * MiB;
constexpr size_t WS_MODS = 8 * MiB;
constexpr size_t WS_ROPE = WS_MODS + 512 * 1024;
constexpr size_t WS_H2 = 9 * MiB;
constexpr size_t WS_HIST = 12 * MiB;
constexpr size_t WS_TOKE = WS_HIST + 65536;
constexpr size_t WS_TOKG = WS_TOKE + (size_t)R_ALL * 8;
constexpr size_t WS_TOKR = WS_TOKG + (size_t)R_ALL * 8;
constexpr size_t WS_TOKS = WS_TOKR + (size_t)R_ALL * 8;
constexpr size_t WS_BLKE = WS_TOKS + (size_t)R_ALL * 8;
static_assert(WS_BLKE + 4096 <= 16 * MiB, "misc region");
constexpr size_t WS_WSM = 16 * MiB;
constexpr size_t WSM_LAYER = 15 * MiB, WSM_WINA = 0, WSM_WINU = 7 * MiB, WSM_WAP = 10 * MiB, WSM_WHP = 12 * MiB, WSM_WOUT = 13 * MiB;
constexpr size_t WS_BTR = WS_WSM + 2 * WSM_LAYER;
constexpr size_t WS_X = 48 * MiB;
constexpr size_t WS_KSPEC = 184 * MiB;
constexpr size_t WS_W13 = 248 * MiB;
constexpr size_t WS_W2T = 376 * MiB;
constexpr size_t WS_OV = 440 * MiB;
constexpr size_t WS_HX = WS_OV, WS_MG = WS_OV;
constexpr size_t WS_Q = WS_OV + 68 * MiB;
constexpr size_t WS_KB = WS_OV + 136 * MiB, WS_VB = WS_OV + 153 * MiB;
constexpr size_t WS_YH = WS_OV + 170 * MiB;
constexpr size_t WS_YHT = WS_OV + 204 * MiB;
constexpr size_t WS_UT = WS_OV + 238 * MiB;
constexpr size_t WS_G = WS_OV + 340 * MiB;
constexpr size_t WS_XS = WS_OV + 68 * MiB, WS_Y = WS_XS;
constexpr size_t WS_HXS = WS_OV + 236 * MiB, WS_HMID = WS_HXS;
constexpr size_t WS_LOG = WS_OV + 372 * MiB;
constexpr size_t WS_END = WS_OV + 476 * MiB;
static_assert((size_t)R_ALL * 1024 * 2 <= 68 * MiB && (size_t)NB * SKV * 256 * 2 <= 17 * MiB && (size_t)R_ALL * 512 * 2 <= 34 * MiB && (size_t)1536 * R_ALL * 2 <= 102 * MiB, "sizes");
static_assert((size_t)NSLOT_MAX * 1024 * 2 <= 168 * MiB && (size_t)R_ALL * 2048 * 2 <= 136 * MiB && (size_t)R_ALL * 128 * 4 <= 17 * MiB && (size_t)R_ALL * 1024 * 4 <= 136 * MiB, "sizes2");
constexpr int CW_BAR = 4096;
constexpr int RING_BYTES = 139264, MISC_OFF = RING_BYTES + 320, LDS_BYTES = 147456;

#define GAS __attribute__((address_space(1)))
#define LAS __attribute__((address_space(3)))
typedef unsigned short bf16;
typedef unsigned v4u __attribute__((ext_vector_type(4)));
typedef unsigned v2u __attribute__((ext_vector_type(2)));
typedef float f32x4 __attribute__((ext_vector_type(4)));
typedef float f32x2 __attribute__((ext_vector_type(2)));
__device__ __forceinline__ unsigned f2bf(float f) { unsigned u = __builtin_bit_cast(unsigned, f); return (u + 0x7fffu + ((u >> 16) & 1u)) >> 16; }
__device__ __forceinline__ unsigned pk2(float lo, float hi) { return f2bf(lo) | (f2bf(hi) << 16); }
__device__ __forceinline__ float bf2f(unsigned b) { return __uint_as_float(b << 16); }
__device__ __forceinline__ float wave_sum(float v) {
#pragma unroll
    for (int o = 1; o < 64; o <<= 1) v += __shfl_xor(v, o);
    return v;
}
#define LDS_WAIT() asm volatile("s_waitcnt lgkmcnt(0)" ::: "memory")
__device__ __forceinline__ void* opaque_uptr(const void* p) {
    unsigned lo = (unsigned)(uintptr_t)p, hi = (unsigned)((uintptr_t)p >> 32);
    asm volatile("" : "+v"(lo), "+v"(hi));
    lo = __builtin_amdgcn_readfirstlane(lo); hi = __builtin_amdgcn_readfirstlane(hi);
    return (void*)(((uintptr_t)hi << 32) | (uintptr_t)lo);
}
constexpr int PTAB_OFF = RING_BYTES + 1024;
struct InTab { LAS const unsigned long long* t;
    __device__ __forceinline__ const float* operator[](int i) const { const unsigned long long v = t[i];
        const unsigned lo = __builtin_amdgcn_readfirstlane((unsigned)v), hi = __builtin_amdgcn_readfirstlane((unsigned)(v >> 32)); return (const float*)(const GAS float*)(((uintptr_t)hi << 32) | (uintptr_t)lo); } };
__device__ __forceinline__ int opaque_u32(int x) { unsigned v = (unsigned)x; asm volatile("" : "+v"(v)); return (int)__builtin_amdgcn_readfirstlane(v); }
#define XB_TMO      128
#define XB_XCNT(j)  (256  + 64 * (j))
#define XB_XSUB(j)  (1280 + 64 * (j))
#define XB_XGEN(j)  (2304 + 64 * (j))
#define XB_TOP      3328
#define XB_TOPGEN   3392
#define XCD_BAR_WORDS 3456
#define XB_SPIN_CAP (1u << 18)

__device__ __forceinline__ unsigned xb_ld(unsigned* p)              { return __hip_atomic_load(p, __ATOMIC_RELAXED, __HIP_MEMORY_SCOPE_AGENT); }
__device__ __forceinline__ unsigned xb_add(unsigned* p, unsigned v) { return __hip_atomic_fetch_add(p, v, __ATOMIC_RELAXED, __HIP_MEMORY_SCOPE_AGENT); }
__device__ __forceinline__ unsigned xb_xcc_id() { return (unsigned)__builtin_amdgcn_s_getreg((3 << 11) | 20) & 0xFu; }
#define XB_SPIN(cond, bar) do { unsigned _sp = 0; while (cond) { __builtin_amdgcn_s_sleep(1); \
    if ((++_sp & 255u) == 0u) { if (xb_ld(&(bar)[XB_TMO])) break; if (_sp > XB_SPIN_CAP) { atomicAdd(&(bar)[XB_TMO], 1u); break; } } } } while (0)

struct XcdBarrier {
    unsigned* bar; unsigned x;
    volatile LAS unsigned* st;
};

__device__ __forceinline__ XcdBarrier xcd_barrier_post(unsigned* bar, volatile LAS unsigned* st) {
    XcdBarrier b; b.bar = bar; b.x = xb_xcc_id(); b.st = st;
    if (threadIdx.x == 0) (void)xb_add(&bar[XB_XCNT(b.x)], 1u);
    return b;
}
__device__ __forceinline__ void xcd_barrier_complete(unsigned* bar, unsigned x, unsigned& nloc, unsigned& nx) {
    const unsigned G = gridDim.x * gridDim.y * gridDim.z;
    unsigned sum, cnt, mine, sp = 0u;
    for (;;) {
        sum = 0u; cnt = 0u; mine = 0u;
#pragma unroll
        for (unsigned j = 0; j < 16; ++j) { const unsigned c = xb_ld(&bar[XB_XCNT(j)]); sum += c; cnt += (c > 0u) ? 1u : 0u; mine = (j == x) ? c : mine; }
        if (sum == G) break;
        __builtin_amdgcn_s_sleep(1);
        if ((++sp & 255u) == 0u) { if (xb_ld(&bar[XB_TMO])) break; if (sp > XB_SPIN_CAP) { atomicAdd(&bar[XB_TMO], 1u); break; } }
    }
    nloc = mine > 0u ? mine : 1u; nx = cnt > 0u ? cnt : 1u;
}

__device__ __forceinline__ void xcd_barrier(const XcdBarrier& b) {
    asm volatile("s_waitcnt vmcnt(0)" ::: "memory");
    __syncthreads();
    if (threadIdx.x == 0) {
        unsigned* bar = b.bar;
        __builtin_amdgcn_s_waitcnt(0);
        unsigned nloc = b.st[0], nx = b.st[1];
        if (nloc == 0u) { xcd_barrier_complete(bar, b.x, nloc, nx); b.st[0] = nloc; b.st[1] = nx; }
        const unsigned old = xb_add(&bar[XB_XSUB(b.x)], 1u);
        const unsigned gen = old / nloc;
        if (old + 1u == (gen + 1u) * nloc) {
            __builtin_amdgcn_fence(__ATOMIC_RELEASE, "agent");
            asm volatile("s_waitcnt vmcnt(0)" ::: "memory");
            const unsigned og = xb_add(&bar[XB_TOP], 1u);
            const unsigned tg = og / nx;
            if (og + 1u == (tg + 1u) * nx) xb_add(&bar[XB_TOPGEN], 1u);
            else XB_SPIN(xb_ld(&bar[XB_TOPGEN]) == tg, bar);
            __builtin_amdgcn_fence(__ATOMIC_ACQUIRE, "agent");
            xb_add(&bar[XB_XGEN(b.x)], 1u);
            asm volatile("s_waitcnt vmcnt(0)" ::: "memory");
        } else {
            XB_SPIN(xb_ld(&bar[XB_XGEN(b.x)]) == gen, bar);
            __builtin_amdgcn_fence(__ATOMIC_ACQUIRE, "agent");
            asm volatile("s_waitcnt vmcnt(0)" ::: "memory");
        }
    }
    __syncthreads();
}

#define HD __device__ __forceinline__
#define FLDS LAS
#define SINCOSPI(x, s, c) sincospif(x, s, c)
#define SHFL_XOR1(x) __shfl_xor(x, 1)
__device__ __forceinline__ f32x2 opaque_f2(f32x2 a) { asm volatile("" : "+v"(a)); return a; }
#define OPAQUE(x) opaque_f2(x)
HD f32x2 cmul(f32x2 a, f32x2 b) { return (f32x2){a.x * b.x - a.y * b.y, a.x * b.y + a.y * b.x}; }
HD f32x2 cmulc(f32x2 a, f32x2 b) { return (f32x2){a.x * b.x + a.y * b.y, a.y * b.x - a.x * b.y}; }
template <int SG> HD f32x2 muli(f32x2 a) { return SG < 0 ? (f32x2){a.y, -a.x} : (f32x2){-a.y, a.x}; }
template <int SG> HD void dft4(f32x2& a0, f32x2& a1, f32x2& a2, f32x2& a3) {
    const f32x2 t0 = a0 + a2, t1 = a0 - a2, t2 = a1 + a3, t3 = muli<SG>(a1 - a3);
    a0 = t0 + t2; a2 = t0 - t2; a1 = t1 + t3; a3 = t1 - t3;
}
template <int SG, int P> HD f32x2 tw16() {
    constexpr float C[16] = {1.f, 0.92387953251128674f, 0.70710678118654752f, 0.38268343236508977f, 0.f, -0.38268343236508977f, -0.70710678118654752f, -0.92387953251128674f,
                             -1.f, -0.92387953251128674f, -0.70710678118654752f, -0.38268343236508977f, 0.f, 0.38268343236508977f, 0.70710678118654752f, 0.92387953251128674f};
    constexpr float S[16] = {0.f, 0.38268343236508977f, 0.70710678118654752f, 0.92387953251128674f, 1.f, 0.92387953251128674f, 0.70710678118654752f, 0.38268343236508977f,
                             0.f, -0.38268343236508977f, -0.70710678118654752f, -0.92387953251128674f, -1.f, -0.92387953251128674f, -0.70710678118654752f, -0.38268343236508977f};
    return (f32x2){C[P & 15], (float)SG * S[P & 15]};
}
template <int SG> HD void bfly4(float& ar, float& ai, float& br, float& bi, float& cr, float& ci, float& dr, float& di) {
    const float t0r = ar + cr, t0i = ai + ci, t1r = ar - cr, t1i = ai - ci, t2r = br + dr, t2i = bi + di;
    const float ur = br - dr, ui = bi - di;
    const float t3r = SG < 0 ? ui : -ui, t3i = SG < 0 ? -ur : ur;
    ar = t0r + t2r; ai = t0i + t2i; cr = t0r - t2r; ci = t0i - t2i; br = t1r + t3r; bi = t1i + t3i; dr = t1r - t3r; di = t1i - t3i;
}
template <int SG, int P> HD void twm(float& r, float& i) { const f32x2 w = tw16<SG, P>(); const float nr = r * w.x - i * w.y, ni = r * w.y + i * w.x; r = nr; i = ni; }
template <int SG> HD void dft16(f32x2 (&v)[16]) {
    float r[16], m[16];
#pragma unroll
    for (int k = 0; k < 16; ++k) { r[k] = v[k].x; m[k] = v[k].y; }
    bfly4<SG>(r[0], m[0], r[4], m[4], r[8], m[8], r[12], m[12]); bfly4<SG>(r[1], m[1], r[5], m[5], r[9], m[9], r[13], m[13]);
    bfly4<SG>(r[2], m[2], r[6], m[6], r[10], m[10], r[14], m[14]); bfly4<SG>(r[3], m[3], r[7], m[7], r[11], m[11], r[15], m[15]);
    twm<SG, 1>(r[5], m[5]); twm<SG, 2>(r[6], m[6]); twm<SG, 3>(r[7], m[7]);
    twm<SG, 2>(r[9], m[9]); twm<SG, 4>(r[10], m[10]); twm<SG, 6>(r[11], m[11]);
    twm<SG, 3>(r[13], m[13]); twm<SG, 6>(r[14], m[14]); twm<SG, 9>(r[15], m[15]);
    bfly4<SG>(r[0], m[0], r[1], m[1], r[2], m[2], r[3], m[3]); bfly4<SG>(r[4], m[4], r[5], m[5], r[6], m[6], r[7], m[7]);
    bfly4<SG>(r[8], m[8], r[9], m[9], r[10], m[10], r[11], m[11]); bfly4<SG>(r[12], m[12], r[13], m[13], r[14], m[14], r[15], m[15]);
#pragma unroll
    for (int c = 0; c < 4; ++c)
#pragma unroll
        for (int d = 0; d < 4; ++d) v[c + 4 * d] = (f32x2){r[4 * c + d], m[4 * c + d]};
}
#ifndef TIE2
#define TIE2(a, b) asm volatile("" : "+v"(a), "+v"(b))
#endif
struct FftTw { f32x2 wA, wC, wI2b, wI2s, wI1b, wI1s; };
HD f32x2 cispi(float x) { float s, c; SINCOSPI(x, &s, &c); return (f32x2){c, s}; }
HD FftTw fft_tw_init(int tid) {
    FftTw w;
    const int m2 = tid & 31, k1 = tid >> 5, j1 = (tid >> 1) & 15, b = tid & 1;
    w.wA = cispi(-2.f * (float)tid / 8192.f);
    w.wC = cispi(-2.f * (float)m2 / 512.f);
    w.wI2b = cispi(-2.f * (float)((m2 * k1) & 8191) / 8192.f);
    w.wI2s = cispi(-2.f * (float)k1 / 256.f);
    w.wI1b = cispi(-2.f * (float)((b * j1) & 31) / 32.f);
    w.wI1s = cispi(-2.f * (float)j1 / 512.f);
    return w;
}
#define FFT_LDS_ELEMS (256 * 33)
HD void fft_fA(int tid, f32x2 (&v)[16], const FftTw& w, FLDS f32x2* L) {
    dft16<-1>(v);
    const f32x2 wA = OPAQUE(w.wA); f32x2 p = wA;
    const int q = tid >> 5, col = tid & 31;
    L[(0 * 16 + q) * 33 + col] = v[0];
#pragma unroll
    for (int k1 = 1; k1 < 16; ++k1) { TIE2(p, v[k1]); L[(k1 * 16 + q) * 33 + col] = cmul(v[k1], p); p = cmul(p, wA); }
}
HD void fft_fC1(int tid, const FftTw& w, FLDS f32x2* L) {
    const int k1 = tid >> 5, m2 = tid & 31;
    f32x2 v[16];
#pragma unroll
    for (int m1 = 0; m1 < 16; ++m1) v[m1] = L[(k1 * 16 + m1) * 33 + m2];
    dft16<-1>(v);
    const f32x2 wC = OPAQUE(w.wC); f32x2 p = wC;
    L[(k1 * 16 + 0) * 33 + m2] = v[0];
#pragma unroll
    for (int j1 = 1; j1 < 16; ++j1) { TIE2(p, v[j1]); L[(k1 * 16 + j1) * 33 + m2] = cmul(v[j1], p); p = cmul(p, wC); }
}
HD void fft_fC3(int tid, f32x2 (&v)[16], FLDS f32x2* L) {
    const int row = tid >> 1, b = tid & 1;
#pragma unroll
    for (int m = 0; m < 16; ++m) {
        const f32x2 lo = L[row * 33 + m], hi = L[row * 33 + m + 16];
        v[m] = b ? (lo - hi) : (lo + hi);
    }
    if (b) {
#define TW32(M) v[M] = cmul(v[M], (f32x2){C32[M], -S32[M]})
        constexpr float C32[16] = {1.f, 0.98078528040323043f, 0.92387953251128674f, 0.83146961230254524f, 0.70710678118654752f, 0.55557023301960218f, 0.38268343236508977f, 0.19509032201612825f,
                                   0.f, -0.19509032201612825f, -0.38268343236508977f, -0.55557023301960218f, -0.70710678118654752f, -0.83146961230254524f, -0.92387953251128674f, -0.98078528040323043f};
        constexpr float S32[16] = {0.f, 0.19509032201612825f, 0.38268343236508977f, 0.55557023301960218f, 0.70710678118654752f, 0.83146961230254524f, 0.92387953251128674f, 0.98078528040323043f,
                                   1.f, 0.98078528040323043f, 0.92387953251128674f, 0.83146961230254524f, 0.70710678118654752f, 0.55557023301960218f, 0.38268343236508977f, 0.19509032201612825f};
        TW32(1); TW32(2); TW32(3); TW32(4); TW32(5); TW32(6); TW32(7); TW32(8); TW32(9); TW32(10); TW32(11); TW32(12); TW32(13); TW32(14); TW32(15);
#undef TW32
    }
    dft16<-1>(v);
}
HD void fft_iI1(int tid, f32x2 (&v)[16], const FftTw& w, FLDS f32x2* L) {
    const int row = tid >> 1, b = tid & 1;
    dft16<1>(v);
    if (b) {
        constexpr float C32[16] = {1.f, 0.98078528040323043f, 0.92387953251128674f, 0.83146961230254524f, 0.70710678118654752f, 0.55557023301960218f, 0.38268343236508977f, 0.19509032201612825f,
                                   0.f, -0.19509032201612825f, -0.38268343236508977f, -0.55557023301960218f, -0.70710678118654752f, -0.83146961230254524f, -0.92387953251128674f, -0.98078528040323043f};
        constexpr float S32[16] = {0.f, 0.19509032201612825f, 0.38268343236508977f, 0.55557023301960218f, 0.70710678118654752f, 0.83146961230254524f, 0.92387953251128674f, 0.98078528040323043f,
                                   1.f, 0.98078528040323043f, 0.92387953251128674f, 0.83146961230254524f, 0.70710678118654752f, 0.55557023301960218f, 0.38268343236508977f, 0.19509032201612825f};
#define TW32(M) v[M] = cmul(v[M], (f32x2){C32[M], S32[M]})
        TW32(1); TW32(2); TW32(3); TW32(4); TW32(5); TW32(6); TW32(7); TW32(8); TW32(9); TW32(10); TW32(11); TW32(12); TW32(13); TW32(14); TW32(15);
#undef TW32
    }
    const f32x2 wb_ = OPAQUE(w.wI1b), ws_ = OPAQUE(w.wI1s);
    f32x2 p = (f32x2){wb_.x, -wb_.y};
    const f32x2 st = (f32x2){ws_.x, -ws_.y};
#pragma unroll
    for (int m = 0; m < 16; ++m) {
        f32x2 o; o.x = SHFL_XOR1(v[m].x); o.y = SHFL_XOR1(v[m].y);
        f32x2 r = b ? (o - v[m]) : (v[m] + o);
        TIE2(p, r); L[row * 33 + m + 16 * b] = cmul(r, p); p = cmul(p, st);
    }
}
HD void fft_iI2(int tid, const FftTw& w, FLDS f32x2* L) {
    const int k1 = tid >> 5, m2 = tid & 31;
    f32x2 v[16];
#pragma unroll
    for (int j1 = 0; j1 < 16; ++j1) v[j1] = L[(k1 * 16 + j1) * 33 + m2];
    dft16<1>(v);
    const f32x2 wb_ = OPAQUE(w.wI2b), ws_ = OPAQUE(w.wI2s);
    f32x2 p = (f32x2){wb_.x, -wb_.y};
    const f32x2 st = (f32x2){ws_.x, -ws_.y};
#pragma unroll
    for (int m1 = 0; m1 < 16; ++m1) { TIE2(p, v[m1]); L[(k1 * 16 + m1) * 33 + m2] = cmul(v[m1], p); p = cmul(p, st); }
}
HD void fft_iI3(int tid, f32x2 (&v)[16], FLDS f32x2* L) {
    const int q = tid >> 5, col = tid & 31;
#pragma unroll
    for (int k1 = 0; k1 < 16; ++k1) v[k1] = L[(k1 * 16 + q) * 33 + col];
    dft16<1>(v);
}
HD void fft_fwd(int tid, f32x2 (&v)[16], const FftTw& tw, LAS f32x2* Lb) {
    fft_fA(tid, v, tw, Lb); __syncthreads(); fft_fC1(tid, tw, Lb); __syncthreads(); fft_fC3(tid, v, Lb); __syncthreads();
}
HD void fft_inv(int tid, f32x2 (&v)[16], const FftTw& tw, LAS f32x2* Lb) {
    fft_iI1(tid, v, tw, Lb); __syncthreads(); fft_iI2(tid, tw, Lb); __syncthreads(); fft_iI3(tid, v, Lb); __syncthreads();
}

__device__ __forceinline__ void tr_item(const float* W, int ldn, int k0, int n0, bf16* WT, int Kd, int drow0, LAS float* scr, int lane) {
#pragma unroll 8
    for (int i = 0; i < 32; ++i) { const int kk = 2 * i + (lane >> 5); scr[kk * 33 + (lane & 31)] = W[(size_t)(k0 + kk) * ldn + n0 + (lane & 31)]; }
    LDS_WAIT(); asm volatile("" ::: "memory");
    const int c = lane & 7;
#pragma unroll
    for (int j = 0; j < 4; ++j) { const int n = (lane >> 3) + 8 * j; const LAS float* s = scr + (8 * c) * 33 + n;
        v4u o; o.x = pk2(s[0 * 33], s[1 * 33]); o.y = pk2(s[2 * 33], s[3 * 33]); o.z = pk2(s[4 * 33], s[5 * 33]); o.w = pk2(s[6 * 33], s[7 * 33]);
        *(GAS v4u*)(WT + (size_t)(drow0 + n) * Kd + k0 + 8 * c) = o; }
    LDS_WAIT(); asm volatile("" ::: "memory");
}
struct Ptrs {
    const float* in[N_IN]; float* out; unsigned char* ws;
};
__device__ __forceinline__ bf16* wsm(unsigned char* ws, int L, size_t off) { return (bf16*)(ws + WS_WSM + (size_t)L * WSM_LAYER + off); }
constexpr int SMALL_ITEMS = 2560 + 512 + 256 + 512, EXPERT_ITEMS = 64 * 768;
__device__ __forceinline__ void conv_small_item(int it, int L, const InTab in, unsigned char* ws, LAS float* scr, int lane) {
    if (it < 2560) { const int kb = it / 160, n0 = 32 * (it % 160); const float* W = in[I_WIN] + (size_t)L * 1024 * INW;
        if (n0 < 1536) tr_item(W, INW, 64 * kb, n0, wsm(ws, L, WSM_WINA), 1024, n0, scr, lane);
        else if (n0 < 3072) tr_item(W, INW, 64 * kb, n0, wsm(ws, L, WSM_WINU), 1024, n0 - 1536, scr, lane);
        else tr_item(W, INW, 64 * kb, n0, wsm(ws, L, WSM_WINA), 1024, n0 - 1536, scr, lane);
        return; }
    it -= 2560;
    if (it < 512) { tr_item(in[I_WAP] + (size_t)L * 1024 * 1024, 1024, 64 * (it / 32), 32 * (it % 32), wsm(ws, L, WSM_WAP), 1024, 32 * (it % 32), scr, lane); return; }
    it -= 512;
    if (it < 256) { tr_item(in[I_WHP] + (size_t)L * 512 * 1024, 1024, 64 * (it / 32), 32 * (it % 32), wsm(ws, L, WSM_WHP), 512, 32 * (it % 32), scr, lane); return; }
    it -= 256;
    tr_item(in[I_WOUT] + (size_t)L * 1024 * 1024, 1024, 64 * (it / 32), 32 * (it % 32), wsm(ws, L, WSM_WOUT), 1024, 32 * (it % 32), scr, lane);
}
__device__ __forceinline__ void conv_expert_item(int it, int L, const InTab in, unsigned char* ws, LAS float* scr, int lane) {
    const int e = it / 768; int r = it % 768; bf16* W13 = (bf16*)(ws + WS_W13); bf16* W2T = (bf16*)(ws + WS_W2T);
    if (r < 512) { const bool third = r >= 256; r &= 255; const int kb = r / 16, n0 = 32 * (r % 16);
        const float* W = in[third ? I_EW3 : I_EW1] + (size_t)(L * NE + e) * 1024 * 512;
        tr_item(W, 512, 64 * kb, n0, W13, 1024, e * 1024 + (n0 >> 7) * 256 + (third ? 128 : 0) + (n0 & 127), scr, lane); return; }
    r -= 512;
    tr_item(in[I_EW2] + (size_t)(L * NE + e) * 512 * 1024, 1024, 64 * (r / 32), 32 * (r % 32), W2T, 512, e * 1024 + 32 * (r % 32), scr, lane);
}
__device__ __forceinline__ void mods_partial_unit(int u, const InTab in, unsigned char* ws, int lane) {
    const int L = u / 384, r0 = u % 384, cg = r0 / 16, ks = r0 % 16, col = cg * 256 + lane * 4;
    f32x4 acc[9];
#pragma unroll
    for (int r = 0; r < 9; ++r) acc[r] = (f32x4){0.f, 0.f, 0.f, 0.f};
    const float* W = in[I_WADA] + (size_t)L * 1024 * 6144 + col; const float* cv = in[I_C]; const float* cc = in[I_CCTX];
#pragma unroll 4
    for (int kk = 0; kk < 64; ++kk) { const int k = ks * 64 + kk; const f32x4 w = *(const f32x4*)(W + (size_t)k * 6144);
#pragma unroll
        for (int r = 0; r < 9; ++r) { const float x = (r < 8) ? cv[r * 1024 + k] : cc[k]; const float s = x / (1.f + expf(-x)); acc[r] += s * w; } }
    float* P = (float*)(ws + WS_MODP) + ((size_t)(ks * 2 + L) * 9) * 6144 + col;
#pragma unroll
    for (int r = 0; r < 9; ++r) *(f32x4*)(P + (size_t)r * 6144) = acc[r];
}
__device__ __forceinline__ void h2_rows(int L, int p0, int pstride, const InTab in, unsigned char* ws, int lane) {
    const float* w1 = in[I_PW1] + (size_t)L * 33 * 64; const float* w2 = in[I_PW2] + (size_t)L * 64 * 64;
    float w1c[33], w2c[64];
#pragma unroll
    for (int i = 0; i < 33; ++i) w1c[i] = w1[i * 64 + lane];
#pragma unroll
    for (int i = 0; i < 64; ++i) w2c[i] = w2[i * 64 + lane];
    const float b1 = in[I_PB1][L * 64 + lane], f1 = in[I_PF1][L * 64 + lane], b2 = in[I_PB2][L * 64 + lane], f2 = in[I_PF2][L * 64 + lane];
    float* H2 = (float*)(ws + WS_H2) + (size_t)L * 4352 * 64;
    for (int p = p0; p < 4352; p += pstride) {
        const int Ls = p < 4096 ? 4096 : 256, pos = p < 4096 ? p : p - 4096;
        float zl = 0.f;
        if (lane == 0) zl = (float)((double)pos / (double)(Ls - 1));
        else if (lane < 33) { const int bi = (lane - 1) & 15; const double band = 1e-4 + (double)bi * ((15.0 - 1e-4) / 15.0);
            const double f = 2.0 * 3.14159265358979323846 * (double)pos * band / (double)Ls;
            zl = lane < 17 ? (float)cos(f) : (float)(-sin(f)); }
        float a = b1;
#pragma unroll
        for (int i = 0; i < 33; ++i) a += __builtin_bit_cast(float, __builtin_amdgcn_readlane(__builtin_bit_cast(int, zl), i)) * w1c[i];
        const float h1 = sinf(f1 * a);
        float a2 = b2;
#pragma unroll
        for (int i = 0; i < 64; ++i) a2 += __builtin_bit_cast(float, __builtin_amdgcn_readlane(__builtin_bit_cast(int, h1), i)) * w2c[i];
        H2[(size_t)p * 64 + lane] = sinf(f2 * a2);
    }
}
struct RowVec { f32x4 v[4]; };
__device__ __forceinline__ float row_sumsq(const RowVec& x) { float s = 0.f;
#pragma unroll
    for (int j = 0; j < 4; ++j) s += (x.v[j].x * x.v[j].x + x.v[j].y * x.v[j].y) + (x.v[j].z * x.v[j].z + x.v[j].w * x.v[j].w);
    return wave_sum(s); }
__device__ __forceinline__ void row_load(RowVec& x, const float* p, int lane) {
#pragma unroll
    for (int j = 0; j < 4; ++j) x.v[j] = *(const f32x4*)(p + 4 * lane + 256 * j); }
__device__ __forceinline__ void row_combine(RowVec& x, int row, const float* g2row, unsigned char* ws, int lane) {
    const int2 s = ((const int2*)(ws + WS_TOKS))[row]; const float2 g = ((const float2*)(ws + WS_TOKG))[row];
    const bf16* Y = (const bf16*)(ws + WS_Y);
#pragma unroll
    for (int j = 0; j < 4; ++j) { const int col = 4 * lane + 256 * j;
        const v2u a = *(const v2u*)(Y + (size_t)s.x * 1024 + col), b = *(const v2u*)(Y + (size_t)s.y * 1024 + col); const f32x4 gg = *(const f32x4*)(g2row + col);
        f32x4 f;
        f.x = g.x * bf2f(a.x & 0xffffu) + g.y * bf2f(b.x & 0xffffu); f.y = g.x * bf2f(a.x >> 16) + g.y * bf2f(b.x >> 16);
        f.z = g.x * bf2f(a.y & 0xffffu) + g.y * bf2f(b.y & 0xffffu); f.w = g.x * bf2f(a.y >> 16) + g.y * bf2f(b.y >> 16);
        x.v[j] += gg * f; }
}
__device__ __forceinline__ void phase_norm1(int L, const InTab in, unsigned char* ws, int gw, int NGW, int lane) {
    const float* mods = (const float*)(ws + WS_MODS); const float* nw = in[I_N1W] + L * 1024;
    float* X = (float*)(ws + WS_X); bf16* HX = (bf16*)(ws + WS_HX);
    for (int row = gw; row < R_ALL; row += NGW) {
        const int mr = row < T_LAT ? row / SEQ : 8;
        RowVec x;
        if (L == 0) row_load(x, row < T_LAT ? in[I_X] + (size_t)row * 1024 : in[I_CTX] + (size_t)(row - T_LAT) * 1024, lane);
        else { row_load(x, X + (size_t)row * 1024, lane); row_combine(x, row, mods + (size_t)(0 * 9 + mr) * 6144 + 5 * 1024, ws, lane);
#pragma unroll
            for (int j = 0; j < 4; ++j) *(f32x4*)(X + (size_t)row * 1024 + 4 * lane + 256 * j) = x.v[j]; }
        const float rstd = rsqrtf(row_sumsq(x) * (1.f / 1024.f) + EPS);
        const float* mrow = mods + (size_t)(L * 9 + mr) * 6144;
#pragma unroll
        for (int j = 0; j < 4; ++j) { const int col = 4 * lane + 256 * j; const f32x4 w = *(const f32x4*)(nw + col), sh = *(const f32x4*)(mrow + col), sc = *(const f32x4*)(mrow + 1024 + col);
            const f32x4 h = (x.v[j] * rstd * w) * (1.f + sc) + sh;
            v2u o; o.x = pk2(h.x, h.y); o.y = pk2(h.z, h.w); *(v2u*)(HX + (size_t)row * 1024 + col) = o; }
    }
}
__device__ __forceinline__ void phase_norm2(int L, int nrows, const InTab in, unsigned char* ws, int gw, int NGW, int lane) {
    const float* mods = (const float*)(ws + WS_MODS); const float* nw = in[I_N2W] + L * 1024;
    const float* X = (const float*)(ws + WS_X); bf16* HXS = (bf16*)(ws + WS_HXS);
    for (int row = gw; row < nrows; row += NGW) {
        const int mr = row < T_LAT ? row / SEQ : 8;
        RowVec x; row_load(x, X + (size_t)row * 1024, lane);
        const float rstd = rsqrtf(row_sumsq(x) * (1.f / 1024.f) + EPS);
        const float* mrow = mods + (size_t)(L * 9 + mr) * 6144;
#pragma unroll
        for (int j = 0; j < 4; ++j) { const int col = 4 * lane + 256 * j; const f32x4 w = *(const f32x4*)(nw + col), sh = *(const f32x4*)(mrow + 3 * 1024 + col), sc = *(const f32x4*)(mrow + 4 * 1024 + col);
            const f32x4 h = (x.v[j] * rstd * w) * (1.f + sc) + sh;
            const unsigned h0 = f2bf(h.x), h1 = f2bf(h.y), h2 = f2bf(h.z), h3 = f2bf(h.w);
            v2u o; o.x = h0 | (h1 << 16); o.y = h2 | (h3 << 16); *(v2u*)(HXS + (size_t)row * 2048 + col) = o;
            v2u l; l.x = pk2(h.x - bf2f(h0), h.y - bf2f(h1)); l.y = pk2(h.z - bf2f(h2), h.w - bf2f(h3)); *(v2u*)(HXS + (size_t)row * 2048 + 1024 + col) = l; }
    }
}
__device__ __forceinline__ void phase_final(const InTab in, float* out, unsigned char* ws, int gw, int NGW, int lane) {
    const float* mods = (const float*)(ws + WS_MODS); const float* nw = in[I_FNW]; const float* X = (const float*)(ws + WS_X);
    for (int row = gw; row < T_LAT; row += NGW) {
        RowVec x; row_load(x, X + (size_t)row * 1024, lane); row_combine(x, row, mods + (size_t)(1 * 9 + row / SEQ) * 6144 + 5 * 1024, ws, lane);
        const float rstd = rsqrtf(row_sumsq(x) * (1.f / 1024.f) + EPS);
#pragma unroll
        for (int j = 0; j < 4; ++j) { const int col = 4 * lane + 256 * j; *(f32x4*)(out + (size_t)row * 1024 + col) = x.v[j] * rstd * *(const f32x4*)(nw + col); }
    }
}
__device__ __forceinline__ void phase_kpost(int L, const InTab in, unsigned char* ws, int gw, int NGW, int lane) {
    bf16* KB = (bf16*)(ws + WS_KB); const float* knw = in[I_KNW] + L * 128; const float2* rope = (const float2*)(ws + WS_ROPE);
    const float w0 = knw[lane], w1 = knw[lane + 64];
    for (int it = gw; it < NB * SKV * NKV; it += NGW) {
        const int kvrow = it >> 1, hd = it & 1, t = kvrow % SKV;
        bf16* p = KB + (size_t)kvrow * 256 + hd * 128;
        float a = bf2f(p[lane]), b = bf2f(p[lane + 64]);
        const float rstd = rsqrtf(wave_sum(a * a + b * b) * (1.f / 128.f) + EPS);
        a *= rstd * w0; b *= rstd * w1;
        if (t < SEQ) { const float2 cs = lane < 32 ? rope[(t >> 6) * 32 + lane] : rope[(t & 63) * 32 + lane - 32]; const float a2 = a * cs.x - b * cs.y, b2 = a * cs.y + b * cs.x; a = a2; b = b2; }
        p[lane] = (bf16)f2bf(a); p[lane + 64] = (bf16)f2bf(b);
    }
}
__device__ __forceinline__ void phase_transpose(unsigned char* ws, LAS unsigned char* lds, int wave, int gw, int NGW, int lane) {
    const bf16* YHT = (const bf16*)(ws + WS_YHT); bf16* YH = (bf16*)(ws + WS_YH);
    LAS bf16* tile = (LAS bf16*)(lds + wave * 9216);
    for (int it = gw; it < 8 * (R_ALL / 64); it += NGW) {
        const int cb = it & 7, rb = it >> 3;
#pragma unroll
        for (int i = 0; i < 8; ++i) { const int ch = i * 8 + (lane >> 3), tk = (lane & 7) * 8;
            const v4u w = *(const v4u*)(YHT + (size_t)(cb * 64 + ch) * R_ALL + rb * 64 + tk);
#pragma unroll
            for (int q = 0; q < 4; ++q) { tile[(tk + 2 * q) * 72 + ch] = (bf16)(w[q] & 0xffffu); tile[(tk + 2 * q + 1) * 72 + ch] = (bf16)(w[q] >> 16); } }
        LDS_WAIT(); asm volatile("" ::: "memory");
#pragma unroll
        for (int i = 0; i < 8; ++i) { const int tk = i * 8 + (lane >> 3), c8 = (lane & 7) * 8;
            const v4u w = *(const LAS v4u*)(tile + tk * 72 + c8);
            *(v4u*)(YH + (size_t)(rb * 64 + tk) * 512 + cb * 64 + c8) = w; }
        LDS_WAIT(); asm volatile("" ::: "memory");
    }
}
__device__ __forceinline__ float hy_delta(int c) { const double mn = -4.605170185988091 / 1.5, mx = -4.605170185988091 / 0.3; const double d = mn + (double)c * ((mx - mn) / 511.0); return (float)(d < 0 ? -d : d); }
__device__ __forceinline__ void filter_fft_unit(int c, int L, const InTab in, unsigned char* ws, LAS unsigned char* lds, int tid, const FftTw& tw) {
    LAS f32x2* Lb = (LAS f32x2*)lds; LAS f32x2* kk = (LAS f32x2*)(lds + 67584); LAS float* w3s = (LAS float*)(lds + 67584 + 65536);
    const float* w3 = in[I_PW3] + (size_t)L * 64 * 2048; const float* H2 = (const float*)(ws + WS_H2) + (size_t)L * 4352 * 64;
    __syncthreads();
    if (tid < 256) w3s[tid] = w3[(size_t)(tid & 63) * 2048 + (tid >> 6) * 512 + c];
    __syncthreads();
    const float delta = hy_delta(c);
#pragma unroll 1
    for (int n1 = 0; n1 < 16; ++n1) {
        const int n = 512 * n1 + tid; const int dir = n1 < 8 ? 0 : 1; const int t = n1 < 8 ? n : (8192 - n) & 4095;
        const f32x4* row = (const f32x4*)(H2 + (size_t)t * 64);
        float d0 = 0.f, d1 = 0.f;
#pragma unroll
        for (int j = 0; j < 16; ++j) { const f32x4 r = row[j]; const LAS float* wa = w3s + dir * 64 + 4 * j; const LAS float* wb = w3s + (2 + dir) * 64 + 4 * j;
            d0 += r.x * wa[0] + r.y * wa[1] + r.z * wa[2] + r.w * wa[3]; d1 += r.x * wb[0] + r.y * wb[1] + r.z * wb[2] + r.w * wb[3]; }
        const float win = (n == 4096) ? 0.f : expf(-((float)t / 4095.f) * delta);
        kk[n1 * 512 + tid] = (f32x2){d0 * win, d1 * win};
    }
    f32x2* K = (f32x2*)(ws + WS_KSPEC);
    f32x2 v[16];
#pragma unroll
    for (int n1 = 0; n1 < 16; ++n1) v[n1] = (f32x2){kk[n1 * 512 + tid].x, 0.f};
    fft_fwd(tid, v, tw, Lb);
#pragma unroll
    for (int a = 0; a < 16; ++a) K[((size_t)(c * 2 + 0) * 512 + tid) * 16 + a] = v[a] * (1.f / 8192.f);
#pragma unroll
    for (int n1 = 0; n1 < 16; ++n1) v[n1] = (f32x2){kk[n1 * 512 + tid].y, 0.f};
    fft_fwd(tid, v, tw, Lb);
#pragma unroll
    for (int a = 0; a < 16; ++a) K[((size_t)(c * 2 + 1) * 512 + tid) * 16 + a] = v[a] * (1.f / 8192.f);
}
__device__ __forceinline__ float sconv(const bf16* row, int t, int len, float w0, float w1, float w2, float b) {
    const float l = t > 0 ? bf2f(row[t - 1]) : 0.f, m = bf2f(row[t]), r = t < len - 1 ? bf2f(row[t + 1]) : 0.f;
    return l * w0 + m * w1 + r * w2 + b;
}
__device__ __forceinline__ float sconv3(const bf16* rp, int tid, bool lv, bool rv, float w0, float w1, float w2, float b) {
    const unsigned l = rp[tid - 1], m = rp[tid], r = rp[tid + 1];
    return (lv ? bf2f(l) : 0.f) * w0 + bf2f(m) * w1 + (rv ? bf2f(r) : 0.f) * w2 + b;
}
__device__ __forceinline__ void hyena_unit(int c, int L, const InTab in, unsigned char* ws, LAS unsigned char* lds, int tid, const FftTw& tw) {
    LAS f32x2* Lb = (LAS f32x2*)lds;
    const float* cw = in[I_HCW] + (size_t)L * 3 * 1536; const float* cb = in[I_HCB] + (size_t)L * 1536; const float* sk = in[I_SKIP] + (size_t)L * 2 * 512;
    const float a0 = cw[c], a1 = cw[1536 + c], a2 = cw[3072 + c], ab = cb[c];
    const float b0 = cw[512 + c], b1 = cw[1536 + 512 + c], b2 = cw[3072 + 512 + c], bb = cb[512 + c];
    const float v0 = cw[1024 + c], v1 = cw[1536 + 1024 + c], v2 = cw[3072 + 1024 + c], vb = cb[1024 + c];
    const float skip0 = sk[c], skip1 = sk[512 + c];
    const bf16* UT = (const bf16*)(ws + WS_UT); bf16* YHT = (bf16*)(ws + WS_YHT);
    const f32x2* K1 = (const f32x2*)(ws + WS_KSPEC) + ((size_t)(c * 2 + 0) * 512 + tid) * 16; const f32x2* K2 = K1 + 16 * 512;
    const bool t_first = tid == 0, t_last = tid == 511;
    __syncthreads();
#pragma unroll 1
    for (int p = 0; p < 4; ++p) {
        const bf16* x1r = UT + (size_t)c * R_ALL + (size_t)(2 * p) * SEQ; const bf16* x2r = UT + (size_t)(512 + c) * R_ALL + (size_t)(2 * p) * SEQ; const bf16* vr = UT + (size_t)(1024 + c) * R_ALL + (size_t)(2 * p) * SEQ;
        bf16* yr = YHT + (size_t)c * R_ALL + (size_t)(2 * p) * SEQ;
        f32x2 v[16]; LAS f32x2* keep = (LAS f32x2*)(lds + 67584) + tid;
#pragma unroll
        for (int n1 = 0; n1 < 8; ++n1) { const bool lv = !(n1 == 0 && t_first), rv = !(n1 == 7 && t_last);
            v[n1] = (f32x2){sconv3(vr + 512 * n1, tid, lv, rv, v0, v1, v2, vb), sconv3(vr + SEQ + 512 * n1, tid, lv, rv, v0, v1, v2, vb)}; keep[n1 * 512] = v[n1]; }
#pragma unroll
        for (int n1 = 8; n1 < 16; ++n1) v[n1] = (f32x2){0.f, 0.f};
        fft_fwd(tid, v, tw, Lb);
#pragma unroll
        for (int a = 0; a < 16; ++a) v[a] = cmul(v[a], K1[a]);
        fft_inv(tid, v, tw, Lb);
#pragma unroll
        for (int n1 = 0; n1 < 8; ++n1) { const bool lv = !(n1 == 0 && t_first), rv = !(n1 == 7 && t_last);
            const f32x2 x1 = (f32x2){sconv3(x1r + 512 * n1, tid, lv, rv, a0, a1, a2, ab), sconv3(x1r + SEQ + 512 * n1, tid, lv, rv, a0, a1, a2, ab)};
            v[n1] = x1 * (v[n1] + skip0 * keep[n1 * 512]); keep[n1 * 512] = v[n1]; }
#pragma unroll
        for (int n1 = 8; n1 < 16; ++n1) v[n1] = (f32x2){0.f, 0.f};
        fft_fwd(tid, v, tw, Lb);
#pragma unroll
        for (int a = 0; a < 16; ++a) v[a] = cmul(v[a], K2[a]);
        fft_inv(tid, v, tw, Lb);
#pragma unroll
        for (int n1 = 0; n1 < 8; ++n1) { const bool lv = !(n1 == 0 && t_first), rv = !(n1 == 7 && t_last);
            const f32x2 x2 = (f32x2){sconv3(x2r + 512 * n1, tid, lv, rv, b0, b1, b2, bb), sconv3(x2r + SEQ + 512 * n1, tid, lv, rv, b0, b1, b2, bb)};
            const f32x2 y = x2 * (v[n1] + skip1 * keep[n1 * 512]);
            yr[512 * n1 + tid] = (bf16)f2bf(y.x); yr[SEQ + 512 * n1 + tid] = (bf16)f2bf(y.y); }
    }
}
__device__ __forceinline__ void hyena_ctx_unit(int c, int L, const InTab in, unsigned char* ws, LAS unsigned char* lds, int tid) {
    LAS float* flt = (LAS float*)lds;
    LAS float* vv = flt + 1024;
    LAS float* zz = vv + 2048;
    const float* w3 = in[I_PW3] + (size_t)L * 64 * 2048; const float* H2 = (const float*)(ws + WS_H2) + ((size_t)L * 4352 + 4096) * 64;
    const float* cw = in[I_HCW] + (size_t)L * 3 * 1536; const float* cb = in[I_HCB] + (size_t)L * 1536; const float* sk = in[I_SKIP] + (size_t)L * 2 * 512;
    const float a0 = cw[c], a1 = cw[1536 + c], a2 = cw[3072 + c], ab = cb[c];
    const float b0 = cw[512 + c], b1 = cw[1536 + 512 + c], b2 = cw[3072 + 512 + c], bb = cb[512 + c];
    const float v0 = cw[1024 + c], v1 = cw[1536 + 1024 + c], v2 = cw[3072 + 1024 + c], vb = cb[1024 + c];
    const float skip0 = sk[c], skip1 = sk[512 + c], delta = hy_delta(c);
    const bf16* UT = (const bf16*)(ws + WS_UT); bf16* YHT = (bf16*)(ws + WS_YHT);
    const bf16* x1r = UT + (size_t)c * R_ALL + T_LAT; const bf16* x2r = UT + (size_t)(512 + c) * R_ALL + T_LAT; const bf16* vr = UT + (size_t)(1024 + c) * R_ALL + T_LAT;
    __syncthreads();
    for (int idx = tid; idx < 1024; idx += NTHR) { const int od = idx >> 8, t = idx & 255; const float* row = H2 + (size_t)t * 64; float d = 0.f;
        for (int j = 0; j < 64; ++j) d += row[j] * w3[(size_t)j * 2048 + od * 512 + c];
        flt[idx] = d * expf(-((float)t / 255.f) * delta); }
    for (int idx = tid; idx < 2048; idx += NTHR) { const int b = idx >> 8, t = idx & 255; vv[idx] = sconv(vr + b * 256, t, 256, v0, v1, v2, vb); }
    __syncthreads();
    for (int idx = tid; idx < 2048; idx += NTHR) { const int b = idx >> 8, t = idx & 255; float y = 0.f;
        for (int s = 0; s <= t; ++s) y += flt[t - s] * vv[b * 256 + s];
        for (int s = t + 1; s < 256; ++s) y += flt[256 + s - t] * vv[b * 256 + s];
        zz[idx] = sconv(x1r + b * 256, t, 256, a0, a1, a2, ab) * (y + skip0 * vv[idx]); }
    __syncthreads();
    for (int idx = tid; idx < 2048; idx += NTHR) { const int b = idx >> 8, t = idx & 255; float y = 0.f;
        for (int s = 0; s <= t; ++s) y += flt[512 + t - s] * zz[b * 256 + s];
        for (int s = t + 1; s < 256; ++s) y += flt[768 + s - t] * zz[b * 256 + s];
        YHT[(size_t)c * R_ALL + T_LAT + idx] = (bf16)f2bf(sconv(x2r + b * 256, t, 256, b0, b1, b2, bb) * (y + skip1 * zz[idx])); }
    __syncthreads();
}
__device__ __forceinline__ void phase_topk(int tpw, const InTab in, unsigned char* ws, LAS unsigned char* lds, int wg, int tid) {
    LAS unsigned* lh = (LAS unsigned*)lds;
    __syncthreads();
    if (tid < 64) lh[tid] = 0u;
    __syncthreads();
    const float* rb = in[I_RB];
    if (tid < tpw) {
        const int tok = wg * tpw + tid; const float* lg = (const float*)(ws + WS_LOG) + (size_t)tok * 128;
        float best = -1e30f; int gsel = 0;
#pragma unroll
        for (int g = 0; g < 8; ++g) { float m1 = -1e30f, m2 = -1e30f;
#pragma unroll
            for (int j = 0; j < 8; ++j) { const int e = g * 8 + j; const float v = 1.f / (1.f + expf(-(lg[e] + lg[64 + e]))) + rb[e];
                if (v > m1) { m2 = m1; m1 = v; } else if (v > m2) m2 = v; }
            const float gs = m1 + m2; if (gs > best) { best = gs; gsel = g; } }
        float sc[8], bi[8];
#pragma unroll
        for (int j = 0; j < 8; ++j) { const int e = gsel * 8 + j; sc[j] = 1.f / (1.f + expf(-(lg[e] + lg[64 + e]))); bi[j] = sc[j] + rb[e]; }
        int i1 = 0; float bm = bi[0], s1 = sc[0];
#pragma unroll
        for (int j = 1; j < 8; ++j) if (bi[j] > bm) { bm = bi[j]; i1 = j; s1 = sc[j]; }
        int i2 = -1; float bm2 = -1e30f, s2 = 0.f;
#pragma unroll
        for (int j = 0; j < 8; ++j) if (j != i1 && bi[j] > bm2) { bm2 = bi[j]; i2 = j; s2 = sc[j]; }
        const int e1 = gsel * 8 + i1, e2 = gsel * 8 + i2; const float inv = 1.f / (s1 + s2);
        const unsigned r1 = atomicAdd((unsigned*)&lh[e1], 1u), r2 = atomicAdd((unsigned*)&lh[e2], 1u);
        ((int2*)(ws + WS_TOKE))[tok] = make_int2(e1, e2); ((float2*)(ws + WS_TOKG))[tok] = make_float2(s1 * inv, s2 * inv); ((int2*)(ws + WS_TOKR))[tok] = make_int2((int)r1, (int)r2);
    }
    __syncthreads();
    if (tid < 64) ((unsigned*)(ws + WS_HIST))[wg * 64 + tid] = lh[tid];
    __syncthreads();
}
__device__ __forceinline__ void phase_gather(int tpw, unsigned char* ws, LAS unsigned char* lds, int wg, int G, int tid, int wave, int lane) {
    LAS int* tot = (LAS int*)lds; LAS int* basew = tot + 64; LAS int* pstart = tot + 128;
    const unsigned* hist = (const unsigned*)(ws + WS_HIST);
    __syncthreads();
    if (tid < 64) { int t = 0, b = 0; for (int w = 0; w < G; ++w) { const int h = (int)hist[w * 64 + tid]; t += h; if (w < wg) b += h; } tot[tid] = t; basew[tid] = b; }
    __syncthreads();
    if (tid == 0) { int acc = 0; for (int e = 0; e < 64; ++e) { pstart[e] = acc; acc += (tot[e] + 255) / 256 * 256; } pstart[64] = acc; }
    __syncthreads();
    if (wg == 0 && tid < 64) { int* be = (int*)(ws + WS_BLKE); for (int b = pstart[tid] / 256; b < pstart[tid + 1] / 256; ++b) be[b] = tid; if (tid == 0) be[512] = pstart[64] / 256; }
    const bf16* HXS = (const bf16*)(ws + WS_HXS); bf16* XS = (bf16*)(ws + WS_XS);
    for (int i = wave; i < tpw; i += NWAVES) { const int tok = wg * tpw + i;
        const int2 e = ((const int2*)(ws + WS_TOKE))[tok], r = ((const int2*)(ws + WS_TOKR))[tok];
        const int s0 = pstart[e.x] + basew[e.x] + r.x, s1 = pstart[e.y] + basew[e.y] + r.y;
        if (lane == 0) ((int2*)(ws + WS_TOKS))[tok] = make_int2(s0, s1);
        const v4u a = *(const v4u*)(HXS + (size_t)tok * 2048 + lane * 8), b = *(const v4u*)(HXS + (size_t)tok * 2048 + 512 + lane * 8);
        *(v4u*)(XS + (size_t)s0 * 1024 + lane * 8) = a; *(v4u*)(XS + (size_t)s0 * 1024 + 512 + lane * 8) = b;
        *(v4u*)(XS + (size_t)s1 * 1024 + lane * 8) = a; *(v4u*)(XS + (size_t)s1 * 1024 + 512 + lane * 8) = b; }
    __syncthreads();
}

constexpr int NPHASES = 27;
struct Args { const float* in[N_IN]; float* out; unsigned char* ws; int ph_lo, ph_hi; };
static_assert(sizeof(Args) == N_IN * 8 + 8 + 8 + 8, "Args has no padding");

__global__ void __launch_bounds__(NTHR, 2) fwd_kernel(Args args) {
    extern __shared__ __attribute__((aligned(16))) unsigned char lds_raw[];
    LAS unsigned char* lds = (LAS unsigned char*)lds_raw;
    volatile LAS unsigned* MISC = (volatile LAS unsigned*)(lds + MISC_OFF);
    const int tid0 = threadIdx.x;
    constexpr int G = 256, NGW = G * NWAVES;
    const int wg0 = blockIdx.x;
#define PH_IDS() int tid = tid0; asm volatile("" : "+v"(tid)); const int wg = opaque_u32(wg0); const int lane = tid & 63, wave = __builtin_amdgcn_readfirstlane(tid >> 6), gw = wg * NWAVES + wave; (void)lane; (void)gw; \
    unsigned char* ws = ws0 + (size_t)(unsigned)opaque_u32(0);     const InTab in{(LAS const unsigned long long*)(lds + PTAB_OFF)}; (void)in
    unsigned char* const ws0 = args.ws;
    for (int u = tid0; u < (LDS_BYTES - RING_BYTES) / 4; u += NTHR) ((LAS unsigned*)(lds + RING_BYTES))[u] = 0u;
    __syncthreads();
    if (tid0 == 0) { LAS unsigned long long* pt = (LAS unsigned long long*)(lds + PTAB_OFF);
#pragma unroll
        for (int i = 0; i < N_IN; ++i) pt[i] = (unsigned long long)(uintptr_t)args.in[i]; }
    __syncthreads();
    unsigned* ctl = (unsigned*)(ws0 + WS_CTL); (void)ctl;
#if MK_PER_PHASE
#define GRID_BAR() do { } while (0)
#else
    XcdBarrier bar = xcd_barrier_post(ctl + CW_BAR, MISC + 8);
#define GRID_BAR() xcd_barrier(bar)
#endif
    const int lo = args.ph_lo, hi = args.ph_hi;
#define IN(k) (lo <= (k) && (k) < hi)
#define SEAM(k) do { if (IN(k) && IN((k) + 1)) GRID_BAR(); } while (0)

    if (IN(0)) { PH_IDS();
        for (int u = gw; u < 768; u += NGW) mods_partial_unit(u, in, ws, lane);
        if (gw >= 768 && gw < 768 + 512) h2_rows((gw - 768) >> 8, (gw - 768) & 255, 256, in, ws, lane);
        for (int i = wg * NTHR + tid; i < 2048; i += G * NTHR) { const int v = i >> 5, j = i & 31; const double ang = (double)v * pow(10000.0, -(double)j / 32.0);
            ((float2*)(ws + WS_ROPE))[i] = make_float2((float)cos(ang), (float)sin(ang)); }
        { const float* rw = in[I_RW]; bf16* BTR = (bf16*)(ws + WS_BTR);
          for (int i = wg * NTHR + tid; i < 256 * 2048; i += G * NTHR) { const int row = i >> 11, k = i & 2047; unsigned o = 0u;
              if (row < 64) o = f2bf(rw[(size_t)(k & 1023) * 64 + row]);
              else if (row < 128 && k < 1024) { const float w = rw[(size_t)k * 64 + row - 64]; o = f2bf(w - bf2f(f2bf(w))); }
              BTR[i] = (bf16)o; } }
        LAS float* scr = (LAS float*)(lds + wave * 16384);
        for (int it = gw; it < 2 * SMALL_ITEMS; it += NGW) conv_small_item(it % SMALL_ITEMS, it / SMALL_ITEMS, in, ws, scr, lane);
        for (int it = gw; it < EXPERT_ITEMS; it += NGW) conv_expert_item(it, 0, in, ws, scr, lane);
    }
    SEAM(0);
    if (IN(1)) { PH_IDS();
        const float* P = (const float*)(ws + WS_MODP); float* M = (float*)(ws + WS_MODS);
        for (int i = wg * NTHR + tid; i < 2 * 9 * 6144; i += G * NTHR) { const int L = i / (9 * 6144), col = i % 6144; float s = in[I_BADA][L * 6144 + col];
            for (int ks = 0; ks < 16; ++ks) s += P[((size_t)(ks * 2 + L) * 9 + (i / 6144) % 9) * 6144 + col];
            M[i] = s; }
    }
    SEAM(1);
    for (int L = 0; L < 2; ++L) {
        const int pb = 2 + 12 * L;
        const int nrows = L == 0 ? R_ALL : T_LAT;
        if (IN(pb + 0)) { PH_IDS();
            phase_norm1(L, in, ws, gw, NGW, lane);
            { const FftTw tw = fft_tw_init(tid); for (int c = wg; c < HYW; c += G) filter_fft_unit(c, L, in, ws, lds, tid, tw); }
            __syncthreads();
            if (L == 1) { LAS float* scr = (LAS float*)(lds + wave * 16384); for (int it = gw; it < EXPERT_ITEMS; it += NGW) conv_expert_item(it, 1, in, ws, scr, lane); }
        }
        SEAM(pb + 0);
        if (IN(pb + 1)) { PH_IDS(); (void)tid; (void)wave;
            { pg8::Gemm g{(const bf16*)(ws + WS_HX), wsm(ws, L, WSM_WINA), R_ALL, NA_COLS, DM}; pg8::StaticOrder S; S.init(R_ALL, NA_COLS, G, wg);
              pg8::EpiQKVG E{(bf16*)(ws + WS_Q), (bf16*)(ws + WS_KB), (bf16*)(ws + WS_VB), (bf16*)(ws + WS_G)};
              pg8::gemm_phase<pg8::EpiQKVG, pg8::StaticOrder, true, true>(lds, g, S, E); }
            { pg8::Gemm g{wsm(ws, L, WSM_WINU), (const bf16*)(ws + WS_HX), NU_COLS, R_ALL, DM}; pg8::StaticOrder S; S.init(NU_COLS, R_ALL, G, wg);
              pg8::EpiStoreBf16 E{(bf16*)(ws + WS_UT), R_ALL, 0x7fffffff};
              pg8::gemm_phase<pg8::EpiStoreBf16, pg8::StaticOrder, true, true>(lds, g, S, E); }
        }
        SEAM(pb + 1);
        if (IN(pb + 2)) { PH_IDS();
            phase_kpost(L, in, ws, gw, NGW, lane);
            { const FftTw tw = fft_tw_init(tid); for (int c = wg; c < HYW; c += G) hyena_unit(c, L, in, ws, lds, tid, tw); }
            if (L == 0) for (int c = wg; c < HYW; c += G) hyena_ctx_unit(c, L, in, ws, lds, tid);
        }
        SEAM(pb + 2);
        if (IN(pb + 3)) { PH_IDS();
            const int vcu = (G % 8 == 0) ? (wg % 8) * (G / 8) + wg / 8 : wg;
            attn::bf16* Q = (attn::bf16*)(ws + WS_Q); const attn::bf16* KB = (const attn::bf16*)(ws + WS_KB); const attn::bf16* VB = (const attn::bf16*)(ws + WS_VB);
            const float* qnw = in[I_QNW] + L * 128; const float2* rope = (const float2*)(ws + WS_ROPE);
            __syncthreads();
            for (int u = vcu; u < 1024; u += G) {
                const int qb = u & 15, hg = (u >> 4) & 3, kvh = (u >> 6) & 1, b = u >> 7, h = kvh * 4 + hg;
                attn::attn_dense_body(Q + (size_t)(b * SEQ + qb * 256) * 1024 + h * 128, KB + (size_t)b * SKV * 256 + kvh * 128, VB + (size_t)b * SKV * 256 + kvh * 128, SKV, (char*)lds_raw, qnw, rope, qb * 256);
            }
            if (L == 0) for (int u = vcu; u < 64; u += G) { const int h = u & 7, b = u >> 3, kvh = h >> 2;
                attn::attn_dense_body(Q + (size_t)(T_LAT + b * CL) * 1024 + h * 128, KB + ((size_t)b * SKV + SEQ) * 256 + kvh * 128, VB + ((size_t)b * SKV + SEQ) * 256 + kvh * 128, CL, (char*)lds_raw, qnw, nullptr, 0); }
            phase_transpose(ws, lds, wave, gw, NGW, lane);
        }
        SEAM(pb + 3);
        if (IN(pb + 4)) { PH_IDS(); (void)tid; (void)wave;
            { pg8::Gemm g{(const bf16*)(ws + WS_Q), wsm(ws, L, WSM_WAP), nrows, DM, DM}; pg8::StaticOrder S; S.init(nrows, DM, G, wg);
              pg8::EpiMerge<false> E{(bf16*)(ws + WS_MG), (const bf16*)(ws + WS_G), 0};
              pg8::gemm_phase<pg8::EpiMerge<false>, pg8::StaticOrder, true, true>(lds, g, S, E); }
            { pg8::Gemm g{(const bf16*)(ws + WS_YH), wsm(ws, L, WSM_WHP), nrows, DM, HYW}; pg8::StaticOrder S; S.init(nrows, DM, G, wg);
              pg8::EpiMerge<true> E{(bf16*)(ws + WS_MG), (const bf16*)(ws + WS_G), 1024};
              pg8::gemm_phase<pg8::EpiMerge<true>, pg8::StaticOrder, true, true>(lds, g, S, E); }
        }
        SEAM(pb + 4);
        if (IN(pb + 5)) { PH_IDS(); (void)tid; (void)wave;
            pg8::Gemm g{(const bf16*)(ws + WS_MG), wsm(ws, L, WSM_WOUT), nrows, DM, DM}; pg8::StaticOrder S; S.init(nrows, DM, G, wg);
            float* X = (float*)(ws + WS_X);
            pg8::EpiResid E{L == 0 ? in[I_X] : X, L == 0 ? in[I_CTX] : X + (size_t)T_LAT * 1024, X, (const float*)(ws + WS_MODS) + (size_t)L * 9 * 6144 + 2 * 1024};
            pg8::gemm_phase<pg8::EpiResid, pg8::StaticOrder, true, true>(lds, g, S, E);
        }
        SEAM(pb + 5);
        if (IN(pb + 6)) { PH_IDS(); phase_norm2(L, nrows, in, ws, gw, NGW, lane); }
        SEAM(pb + 6);
        if (IN(pb + 7)) { PH_IDS(); (void)tid; (void)wave;
            pg8::Gemm g{(const bf16*)(ws + WS_HXS), (const bf16*)(ws + WS_BTR), nrows, 256, 2048}; pg8::StaticOrder S; S.init(nrows, 256, G, wg);
            pg8::EpiLogits E{(float*)(ws + WS_LOG)};
            pg8::gemm_phase<pg8::EpiLogits, pg8::StaticOrder, true, true>(lds, g, S, E);
        }
        SEAM(pb + 7);
        if (IN(pb + 8)) { PH_IDS(); phase_topk(nrows / G, in, ws, lds, wg, tid); }
        SEAM(pb + 8);
        if (IN(pb + 9)) { PH_IDS(); phase_gather(nrows / G, ws, lds, wg, G, tid, wave, lane); }
        SEAM(pb + 9);
        if (IN(pb + 10)) { PH_IDS(); (void)tid; (void)wave;
            const int* be = (const int*)(ws + WS_BLKE); const int nblk = be[512];
            pg8::Gemm g{(const bf16*)(ws + WS_XS), (const bf16*)(ws + WS_W13), nblk * 256, 1024, DM}; pg8::MoeOrder S; S.init(nblk, be, G, wg);
            pg8::EpiSwiGLU E{(bf16*)(ws + WS_HMID)};
            pg8::gemm_phase<pg8::EpiSwiGLU, pg8::MoeOrder, true, true>(lds, g, S, E);
        }
        SEAM(pb + 10);
        if (IN(pb + 11)) { PH_IDS(); (void)tid; (void)wave;
            const int* be = (const int*)(ws + WS_BLKE); const int nblk = be[512];
            pg8::Gemm g{(const bf16*)(ws + WS_HMID), (const bf16*)(ws + WS_W2T), nblk * 256, 1024, EDIM}; pg8::MoeOrder S; S.init(nblk, be, G, wg);
            pg8::EpiStoreBf16 E{(bf16*)(ws + WS_Y), 1024, 3};
            pg8::gemm_phase<pg8::EpiStoreBf16, pg8::MoeOrder, true, true>(lds, g, S, E);
        }
        SEAM(pb + 11);
    }
    if (IN(26)) { PH_IDS(); phase_final(in, args.out, ws, gw, NGW, lane); }
#undef IN
#undef SEAM
}

extern "C" void kernel_launch(void* const* d_in, const int* in_sizes, int n_in, void* d_out, int out_size, void* d_ws, size_t ws_size, hipStream_t stream) {
    static int grid = 0;
    if (grid == 0) {
        if (n_in != N_IN || in_sizes[0] != T_LAT * DM || out_size != T_LAT * DM || ws_size < WS_END) {
            fprintf(stderr, "kernel_launch: shape mismatch (n_in %d in0 %d out %d ws %zu, need ws >= %zu); nothing launched\n", n_in, n_in > 0 ? in_sizes[0] : -1, out_size, ws_size, (size_t)WS_END); grid = -1; return; }
        int dev = 0, cus = 0, per_cu = 0;
        if (hipGetDevice(&dev) != hipSuccess || hipDeviceGetAttribute(&cus, hipDeviceAttributeMultiprocessorCount, dev) != hipSuccess) { grid = -1; return; }
        if (hipFuncSetAttribute((const void*)fwd_kernel, hipFuncAttributeMaxDynamicSharedMemorySize, LDS_BYTES) != hipSuccess) { fprintf(stderr, "kernel_launch: hipFuncSetAttribute failed\n"); grid = -1; return; }
        if (hipOccupancyMaxActiveBlocksPerMultiprocessor(&per_cu, (const void*)fwd_kernel, NTHR, LDS_BYTES) != hipSuccess || per_cu < 1) fprintf(stderr, "kernel_launch: occupancy query says %d\n", per_cu);
        (void)hipGetLastError();
        if (cus < 256) { fprintf(stderr, "kernel_launch: %d CUs < 256; nothing launched\n", cus); grid = -1; return; }
        grid = 256;
    }
    if (grid < 0) return;
    (void)hipMemsetAsync((char*)d_ws + WS_CTL, 0, CTL_ZERO_BYTES, stream);
    Args a{};
    for (int i = 0; i < N_IN; ++i) a.in[i] = (const float*)d_in[i];
    a.out = (float*)d_out; a.ws = (unsigned char*)d_ws;
#if MK_PER_PHASE
    for (int p = 0; p < NPHASES; ++p) { a.ph_lo = p; a.ph_hi = p + 1; hipLaunchKernelGGL(fwd_kernel, dim3(grid), dim3(NTHR), LDS_BYTES, stream, a); }
#else
    a.ph_lo = 0; a.ph_hi = NPHASES; hipLaunchKernelGGL(fwd_kernel, dim3(grid), dim3(NTHR), LDS_BYTES, stream, a);
#endif
    const hipError_t le = hipPeekAtLastError();
    if (le != hipSuccess) fprintf(stderr, "kernel_launch: launch failed: %s\n", hipGetErrorName(le));
}
```

```cpp
#include <hip/hip_runtime.h>
#include <cstdio>
#include <cstdint>

#ifndef MK_PER_PHASE
#define MK_PER_PHASE 0
#endif

namespace pg8 {
#define PG8_LAS __attribute__((address_space(3)))
typedef unsigned short bf16_t;
typedef short bf16x8 __attribute__((ext_vector_type(8)));
typedef float f32x4 __attribute__((ext_vector_type(4)));
typedef unsigned u32x4 __attribute__((ext_vector_type(4)));
constexpr int BM = 256, BK = 64, HALF = 128, HTB = HALF * BK * 2  , STAGE_BYTES = 8 * HTB, NXCD = 8, WGM = 8;

__host__ __device__ __forceinline__ int lds_byte(int r, int c) { const int st = (r >> 4) * 2 + (c >> 5), rr = r & 15, cc = c & 31, ob = rr * 64 + cc * 2; return st * 1024 + (ob ^ (((ob >> 9) & 1) << 5)); }
__host__ __device__ __forceinline__ void stage_rc(int b, int& R, int& C) { const int st = b / 1024, sb = b % 1024, swz = sb ^ (((sb >> 9) & 1) << 5); R = (st >> 1) * 16 + swz / 64; C = (st & 1) * 32 + (swz % 64) / 2; }
__host__ __device__ __forceinline__ int perm32(int rho) { const int n = rho >> 4, i = rho & 15; return 8 * (i >> 2) + 4 * n + (i & 3); }

struct Unit { int pm, pn; };
struct Gemm { const bf16_t* A; const bf16_t* Bt; int M, N, K; };

struct StaticOrder {
    static constexpr bool GATHER = false; __device__ __forceinline__ const int* rowtab() const { return nullptr; } __device__ __forceinline__ int lda_bytes() const { return 0; }
    int nM, nN, nwg, G, c;
    __host__ __device__ void init(int M, int N, int G_, int c_) { nM = M / BM; nN = N / BM; nwg = nM * nN; G = G_; c = c_; }
    __host__ __device__ bool next(int i, Unit& u) const {
        const long L = (long)i * G + c; if (L >= nwg) return false;
        int wgid = (int)L; { const int q = nwg / NXCD, r = nwg % NXCD, xcd = wgid % NXCD, off = wgid / NXCD; wgid = (xcd < r ? xcd * (q + 1) : r * (q + 1) + (xcd - r) * q) + off; }
        const int nig = WGM * nN, gid = wgid / nig, fm = gid * WGM, gsz = (nM - fm) < WGM ? (nM - fm) : WGM;
        u.pm = fm + ((wgid % nig) % gsz); u.pn = (wgid % nig) / gsz; return true;
    }
    __device__ __forceinline__ void a_ready(const Unit&) const {}
    __device__ __forceinline__ void done(const Unit&) const {}
};

__device__ __forceinline__ unsigned cvt_pk_bf16(float lo, float hi) { unsigned r; asm volatile("v_cvt_pk_bf16_f32 %0, %1, %2" : "=v"(r) : "v"(lo), "v"(hi)); return r; }
typedef float f32x2 __attribute__((ext_vector_type(2)));
__device__ __forceinline__ float bf2f(unsigned b) { return __uint_as_float(b << 16); }
__device__ __forceinline__ float sigm(float x) { return __builtin_amdgcn_rcpf(1.f + __builtin_amdgcn_exp2f(-1.4426950408889634f * x)); }
__device__ __forceinline__ u32x4 pack8(const f32x4& v0, const f32x4& v1) { u32x4 w; w.x = cvt_pk_bf16(v0[0], v0[1]); w.y = cvt_pk_bf16(v0[2], v0[3]); w.z = cvt_pk_bf16(v1[0], v1[1]); w.w = cvt_pk_bf16(v1[2], v1[3]); return w; }
__device__ __forceinline__ void unpack8(const u32x4& w, f32x4& v0, f32x4& v1) {
    v0[0] = bf2f(w.x & 0xffffu); v0[1] = bf2f(w.x >> 16); v0[2] = bf2f(w.y & 0xffffu); v0[3] = bf2f(w.y >> 16);
    v1[0] = bf2f(w.z & 0xffffu); v1[1] = bf2f(w.z >> 16); v1[2] = bf2f(w.w & 0xffffu); v1[3] = bf2f(w.w >> 16); }

struct EpiStoreBf16 {
    static constexpr int MIDK = 0; static constexpr bool PERM = true, AFTER_DRAIN = false;
    bf16_t* O; int ldc; int pn_mask;
    __device__ __forceinline__ void operator()(const f32x4 (&acc)[2][2][4][2], const Unit& u, int wr, int wc, int fr, int fq) const {
        bf16_t* base = O + (size_t)(u.pm * BM + wr * 64 + fr) * ldc + (u.pn & pn_mask) * BM + wc * 32 + 8 * fq;
#pragma unroll
        for (int ai = 0; ai < 2; ++ai)
#pragma unroll
            for (int m = 0; m < 4; ++m) { bf16_t* rowp = base + (size_t)(ai * HALF + m * 16) * ldc;
#pragma unroll
                for (int bj = 0; bj < 2; ++bj) *(u32x4*)(rowp + bj * HALF) = pack8(acc[ai][bj][m][0], acc[ai][bj][m][1]); }
    }
};
struct EpiQKVG {
    static constexpr int MIDK = 0; static constexpr bool PERM = true, AFTER_DRAIN = false;
    bf16_t *Q, *KB, *VB, *G;
    __device__ __forceinline__ void operator()(const f32x4 (&acc)[2][2][4][2], const Unit& u, int wr, int wc, int fr, int fq) const {
        const int pm = u.pm, pn = u.pn; bf16_t* base; int ldc; bool act = false;
        if (pn < 4) { base = Q + (size_t)(pm * BM) * 1024 + pn * BM; ldc = 1024; }
        else if (pn < 6) { const int kv0 = pm < 128 ? (pm >> 4) * 4352 + (pm & 15) * 256 : (pm - 128) * 4352 + 4096; base = (pn == 4 ? KB : VB) + (size_t)kv0 * 256; ldc = 256; }
        else { base = G + (size_t)(pm * BM) * 2048 + (pn - 6) * BM; ldc = 2048; act = true; }
        base += (size_t)(wr * 64 + fr) * ldc + wc * 32 + 8 * fq;
#pragma unroll
        for (int ai = 0; ai < 2; ++ai)
#pragma unroll
            for (int m = 0; m < 4; ++m) { bf16_t* rowp = base + (size_t)(ai * HALF + m * 16) * ldc;
#pragma unroll
                for (int bj = 0; bj < 2; ++bj) { f32x4 v0 = acc[ai][bj][m][0], v1 = acc[ai][bj][m][1];
                    if (act) {
#pragma unroll
                        for (int i = 0; i < 4; ++i) { v0[i] = sigm(v0[i]); v1[i] = sigm(v1[i]); } }
                    *(u32x4*)(rowp + bj * HALF) = pack8(v0, v1); } }
    }
};
struct EpiMergeCat {
    static constexpr int MIDK = 16; static constexpr bool PERM = true, AFTER_DRAIN = false;
    bf16_t* MG; const bf16_t* G;
    __device__ __forceinline__ void mid(f32x4 (&acc)[2][2][4][2], const Unit& u, int wr, int wc, int fr, int fq) const {
        asm volatile("" : "+v"(fr), "+v"(fq));
        const int row0 = u.pm * BM + wr * 64 + fr, col0 = u.pn * BM + wc * 32 + 8 * fq;
#pragma unroll
        for (int ai = 0; ai < 2; ++ai)
#pragma unroll
            for (int m = 0; m < 4; ++m) { const size_t row = (size_t)(row0 + ai * HALF + m * 16);
#pragma unroll
                for (int bj = 0; bj < 2; ++bj) { const int col = col0 + bj * HALF;
                    const u32x4 ga = *(const u32x4*)(G + row * 2048 + col), gh = *(const u32x4*)(G + row * 2048 + 1024 + col);
                    f32x4 a0, a1, h0, h1; unpack8(ga, a0, a1); unpack8(gh, h0, h1);
#pragma unroll
                    for (int i = 0; i < 4; ++i) { acc[ai][bj][m][0][i] *= a0[i] * __builtin_amdgcn_rcpf(fmaxf(h0[i], 1e-30f)); acc[ai][bj][m][1][i] *= a1[i] * __builtin_amdgcn_rcpf(fmaxf(h1[i], 1e-30f)); } }
                asm volatile("" ::: "memory"); }
    }
    __device__ __forceinline__ void operator()(const f32x4 (&acc)[2][2][4][2], const Unit& u, int wr, int wc, int fr, int fq) const {
        asm volatile("" : "+v"(fr), "+v"(fq));
        const int row0 = u.pm * BM + wr * 64 + fr, col0 = u.pn * BM + wc * 32 + 8 * fq;
#pragma unroll
        for (int ai = 0; ai < 2; ++ai)
#pragma unroll
            for (int m = 0; m < 4; ++m) { const size_t row = (size_t)(row0 + ai * HALF + m * 16);
#pragma unroll
                for (int bj = 0; bj < 2; ++bj) { const int col = col0 + bj * HALF;
                    const u32x4 gh = *(const u32x4*)(G + row * 2048 + 1024 + col); f32x4 h0, h1; unpack8(gh, h0, h1);
#pragma unroll
                    for (int i = 0; i < 4; ++i) { h0[i] = fmaxf(h0[i], 1e-30f); h1[i] = fmaxf(h1[i], 1e-30f); }
                    *(u32x4*)(MG + row * 1024 + col) = pack8(acc[ai][bj][m][0] * h0, acc[ai][bj][m][1] * h1); } }
    }
};
template <bool BASE_BF16> struct EpiResid {
    static constexpr int MIDK = 0; static constexpr bool PERM = true, AFTER_DRAIN = false;
    const void* base_lat; const void* base_ctx; bf16_t* X; const float* g1;
    __device__ __forceinline__ void operator()(const f32x4 (&acc)[2][2][4][2], const Unit& u, int wr, int wc, int fr, int fq) const {
        const int pm = u.pm, row0 = pm * BM + wr * 64 + fr, col0 = u.pn * BM + wc * 32 + 8 * fq;
        const float* gp = g1 + (size_t)(pm < 128 ? (pm >> 4) : 8) * 6144 + col0;
        const size_t boff = pm < 128 ? (size_t)row0 * 1024 + col0 : (size_t)(row0 - 32768) * 1024 + col0; const void* bsrc = pm < 128 ? base_lat : base_ctx;
        bf16_t* xp = X + (size_t)row0 * 1024 + col0;
        f32x4 gv[2][2];
#pragma unroll
        for (int bj = 0; bj < 2; ++bj)
#pragma unroll
            for (int n = 0; n < 2; ++n) gv[bj][n] = *(const f32x4*)(gp + bj * HALF + n * 4);
#pragma unroll
        for (int ai = 0; ai < 2; ++ai)
#pragma unroll
            for (int m = 0; m < 4; ++m) { const size_t ro = (size_t)(ai * HALF + m * 16) * 1024;
#pragma unroll
                for (int bj = 0; bj < 2; ++bj) { f32x4 b0, b1;
                    if (BASE_BF16) { const u32x4 w = *(const u32x4*)((const bf16_t*)bsrc + boff + ro + bj * HALF); unpack8(w, b0, b1); }
                    else { const float* bp = (const float*)bsrc + boff + ro + bj * HALF; b0 = *(const f32x4*)bp; b1 = *(const f32x4*)(bp + 4); }
                    *(u32x4*)(xp + ro + bj * HALF) = pack8(b0 + gv[bj][0] * acc[ai][bj][m][0], b1 + gv[bj][1] * acc[ai][bj][m][1]); } }
    }
};
struct EpiLogits {
    static constexpr int MIDK = 0; static constexpr bool PERM = false, AFTER_DRAIN = false;
    float* LOG;
    __device__ __forceinline__ void operator()(const f32x4 (&acc)[2][2][4][2], const Unit& u, int wr, int wc, int fr, int fq) const {
        float* base = LOG + (size_t)(u.pm * BM + wr * 64 + fr) * 128 + wc * 32 + 4 * fq;
#pragma unroll
        for (int ai = 0; ai < 2; ++ai)
#pragma unroll
            for (int m = 0; m < 4; ++m)
#pragma unroll
                for (int n = 0; n < 2; ++n) *(f32x4*)(base + (size_t)(ai * HALF + m * 16) * 128 + n * 16) = acc[ai][0][m][n];
    }
};
struct EpiTopK {
    static constexpr int MIDK = 0; static constexpr bool PERM = false, AFTER_DRAIN = true;
    const float* rb; int* toke; float* tokg; int* tokr; unsigned* hist;
    __device__ __forceinline__ void fused(f32x4 (&acc)[2][2][4][2], const Unit& u, int wr, int wc, int fr, int fq, PG8_LAS unsigned char* lds, int wid, int lane) const {
        PG8_LAS float* Lg = (PG8_LAS float*)lds; PG8_LAS unsigned* lh = (PG8_LAS unsigned*)(lds + 256 * 132 * 4);
        const int tid = wid * 64 + lane;
        if (tid < 64) lh[tid] = 0u;
#pragma unroll
        for (int ai = 0; ai < 2; ++ai)
#pragma unroll
            for (int m = 0; m < 4; ++m)
#pragma unroll
                for (int n = 0; n < 2; ++n) *(PG8_LAS f32x4*)(Lg + (ai * HALF + wr * 64 + m * 16 + fr) * 132 + wc * 32 + n * 16 + 4 * fq) = acc[ai][0][m][n];
        asm volatile("s_waitcnt lgkmcnt(0)" ::: "memory"); __builtin_amdgcn_s_barrier(); asm volatile("" ::: "memory");
        if (tid < 256) {
            const PG8_LAS float* lg = Lg + tid * 132; const int tok = u.pm * BM + tid;
            float best = -1e30f; int gsel = 0;
#pragma unroll
            for (int g = 0; g < 8; ++g) { float m1 = -1e30f, m2 = -1e30f;
#pragma unroll
                for (int j = 0; j < 8; ++j) { const int e = g * 8 + j; const float v = 1.f / (1.f + expf(-(lg[e] + lg[64 + e]))) + rb[e];
                    if (v > m1) { m2 = m1; m1 = v; } else if (v > m2) m2 = v; }
                const float gs = m1 + m2; if (gs > best) { best = gs; gsel = g; } }
            float sc[8], bi[8];
#pragma unroll
            for (int j = 0; j < 8; ++j) { const int e = gsel * 8 + j; sc[j] = 1.f / (1.f + expf(-(lg[e] + lg[64 + e]))); bi[j] = sc[j] + rb[e]; }
            int i1 = 0; float bm = bi[0], s1 = sc[0];
#pragma unroll
            for (int j = 1; j < 8; ++j) if (bi[j] > bm) { bm = bi[j]; i1 = j; s1 = sc[j]; }
            int i2 = -1; float bm2 = -1e30f, s2 = 0.f;
#pragma unroll
            for (int j = 0; j < 8; ++j) if (j != i1 && bi[j] > bm2) { bm2 = bi[j]; i2 = j; s2 = sc[j]; }
            const int e1 = gsel * 8 + i1, e2 = gsel * 8 + i2; const float inv = 1.f / (s1 + s2);
            const unsigned r1 = __hip_atomic_fetch_add(lh + e1, 1u, __ATOMIC_RELAXED, __HIP_MEMORY_SCOPE_WORKGROUP), r2 = __hip_atomic_fetch_add(lh + e2, 1u, __ATOMIC_RELAXED, __HIP_MEMORY_SCOPE_WORKGROUP);
            toke[2 * tok] = e1; toke[2 * tok + 1] = e2; tokg[2 * tok] = s1 * inv; tokg[2 * tok + 1] = s2 * inv; tokr[2 * tok] = (int)r1; tokr[2 * tok + 1] = (int)r2;
        }
        asm volatile("s_waitcnt lgkmcnt(0)" ::: "memory"); __builtin_amdgcn_s_barrier(); asm volatile("" ::: "memory");
        if (tid < 64) hist[u.pm * 64 + tid] = lh[tid];
    }
};
struct EpiSwiGLU {
    static constexpr int MIDK = 0; static constexpr bool PERM = true, AFTER_DRAIN = false;
    bf16_t* H;
    __device__ __forceinline__ void operator()(const f32x4 (&acc)[2][2][4][2], const Unit& u, int wr, int wc, int fr, int fq) const {
        bf16_t* base = H + (size_t)(u.pm * BM + wr * 64 + fr) * 512 + (u.pn & 3) * 128 + wc * 32 + 8 * fq;
#pragma unroll
        for (int ai = 0; ai < 2; ++ai)
#pragma unroll
            for (int m = 0; m < 4; ++m) { f32x4 v0, v1;
#pragma unroll
                for (int i = 0; i < 4; ++i) { const float a0 = acc[ai][0][m][0][i], a1 = acc[ai][0][m][1][i];
                    v0[i] = a0 * sigm(a0) * acc[ai][1][m][0][i]; v1[i] = a1 * sigm(a1) * acc[ai][1][m][1][i]; }
                *(u32x4*)(base + (size_t)(ai * HALF + m * 16) * 512) = pack8(v0, v1); }
    }
};
struct Gemm1Order {
    static constexpr bool GATHER = false; __device__ __forceinline__ const int* rowtab() const { return nullptr; } __device__ __forceinline__ int lda_bytes() const { return 0; }
    StaticOrder a, b; int hx0, wa0, wu0, nA, nB, G, c;
    __device__ __forceinline__ void init(int hx0_, int wa0_, int wu0_, int G_, int c_, int P) { hx0 = hx0_; wa0 = wa0_; wu0 = wu0_; G = G_; c = c_; nA = P * 14; nB = 6 * P;
        a.init(P * 256, 14 * 256, 1, 0); b.init(6 * 256, P * 256, 1, 0); }
    __device__ __forceinline__ bool next(int i, Unit& u) const { const int L = i * G + c; if (L >= nA + nB) return false; Unit t;
        if (L < nA) { a.next(L, t); u.pm = hx0 + t.pm; u.pn = wa0 + t.pn; } else { b.next(L - nA, t); u.pm = wu0 + t.pm; u.pn = hx0 + t.pn; } return true; }
    __device__ __forceinline__ void a_ready(const Unit&) const {}
    __device__ __forceinline__ void done(const Unit&) const {}
};
struct CtxKVOrder {
    static constexpr bool GATHER = false; __device__ __forceinline__ const int* rowtab() const { return nullptr; } __device__ __forceinline__ int lda_bytes() const { return 0; }
    int hx0, wa0, c;
    __device__ __forceinline__ bool next(int i, Unit& u) const { if (i > 0 || c < 0 || c >= 16) return false; u.pm = hx0 + 128 + (c >> 1); u.pn = wa0 + 4 + (c & 1); return true; }
    __device__ __forceinline__ void a_ready(const Unit&) const {}
    __device__ __forceinline__ void done(const Unit&) const {}
};
struct EpiGemm1 {
    static constexpr int MIDK = 0; static constexpr bool PERM = true, AFTER_DRAIN = false;
    EpiQKVG qk; EpiStoreBf16 ut; int hx0, wa0, wu0;
    __device__ __forceinline__ void operator()(const f32x4 (&acc)[2][2][4][2], const Unit& u, int wr, int wc, int fr, int fq) const {
        if (u.pm >= hx0) { Unit t; t.pm = u.pm - hx0; t.pn = u.pn - wa0; qk(acc, t, wr, wc, fr, fq); }
        else { Unit t; t.pm = u.pm - wu0; t.pn = u.pn - hx0; ut(acc, t, wr, wc, fr, fq); }
    }
};
struct FiltOrder {
    static constexpr bool GATHER = false; __device__ __forceinline__ const int* rowtab() const { return nullptr; } __device__ __forceinline__ int lda_bytes() const { return 0; }
    int c;
    __device__ __forceinline__ bool next(int i, Unit& u) const { if (i > 0 || c >= 256) return false; const int L = c >> 7, w = c & 127; u.pm = L * 8 + (w >> 4); u.pn = L * 16 + (w & 15); return true; }
    __device__ __forceinline__ void a_ready(const Unit&) const {}
    __device__ __forceinline__ void done(const Unit&) const {}
};
struct EpiFilt {
    static constexpr int MIDK = 0; static constexpr bool PERM = false, AFTER_DRAIN = false;
    float* F;
    __device__ __forceinline__ void operator()(const f32x4 (&acc)[2][2][4][2], const Unit& u, int wr, int wc, int fr, int fq) const {
        const int L = u.pm >> 3, col0 = (u.pm & 7) * BM + wr * 64 + fr, t0 = (u.pn & 15) * BM + wc * 32 + 4 * fq;
        float* base = F + ((size_t)L * 2048 + col0) * 4096 + t0;
#pragma unroll
        for (int ai = 0; ai < 2; ++ai)
#pragma unroll
            for (int m = 0; m < 4; ++m) { const int col = col0 + ai * HALF + m * 16; const float dl = -(3.070113457325394f + (float)(col & 511) * 0.024032199274562772f) * (1.4426950408889634f / 4095.f);
#pragma unroll
                for (int bj = 0; bj < 2; ++bj)
#pragma unroll
                    for (int n = 0; n < 2; ++n) { const int t = t0 + bj * HALF + n * 16; f32x4 w;
#pragma unroll
                        for (int q = 0; q < 4; ++q) w[q] = __builtin_amdgcn_exp2f((float)(t + q) * dl);
                        *(f32x4*)(base + (size_t)(ai * HALF + m * 16) * 4096 + bj * HALF + n * 16) = acc[ai][bj][m][n] * w; } }
    }
};
template <bool GATHER_> struct MoeOrderT {
    static constexpr bool GATHER = GATHER_;
    int nunits, G, c; const int* blk_e; const int* rows; int lda_b;
    __device__ __forceinline__ const int* rowtab() const { return rows; } __device__ __forceinline__ int lda_bytes() const { return lda_b; }
    __device__ __forceinline__ void init(int nblk, const int* be, int G_, int c_, const int* rows_ = nullptr, int lda_b_ = 0) { nunits = nblk * 4; blk_e = be; G = G_; c = c_; rows = rows_; lda_b = lda_b_; }
    __device__ __forceinline__ bool next(int i, Unit& u) const { const int x = c & 7, s = c >> 3, blk = 64 * i + 8 * x + (s >> 2); if (blk * 4 >= nunits) return false; u.pm = blk; u.pn = blk_e[blk] * 4 + (s & 3); return true; }
    __device__ __forceinline__ void a_ready(const Unit&) const {}
    __device__ __forceinline__ void done(const Unit&) const {}
};
typedef MoeOrderT<false> MoeOrder;
typedef MoeOrderT<true> MoeGatherOrder;

template <class Epi, class Sched, bool ALIGN_EPI = false, bool SP2 = false>
__device__ __forceinline__ void gemm_phase(PG8_LAS unsigned char* lds, const Gemm g, const Sched& S, const Epi& E, int tid_in) {
    int tid = tid_in; asm volatile("" : "+v"(tid));
    const int wid = __builtin_amdgcn_readfirstlane(tid >> 6), lane = tid & 63, wr = wid >> 2, wc = wid & 3, fr = lane & 15, fq = lane >> 4;
    const int K = g.K, nt = K / BK;
    constexpr bool GATHER = Sched::GATHER;
    unsigned vAc[2][2], vAn[2][2], voffB[2]; int RA[2], CA2[2];
#pragma unroll
    for (int i = 0; i < 2; ++i) { int R, C; stage_rc(tid * 16 + i * 8192, R, C); const int Rb = Epi::PERM ? ((R & ~31) + perm32(R & 31)) : R;
        RA[i] = R; CA2[i] = C * 2; voffB[i] = (unsigned)(Rb * K + C) * 2u;
#pragma unroll
        for (int h = 0; h < 2; ++h) { vAc[h][i] = (unsigned)((R + h * HALF) * K + C) * 2u; vAn[h][i] = vAc[h][i]; } }
    PG8_LAS int* gtab = (PG8_LAS int*)(lds + STAGE_BYTES);
#define PG8_GVOFF(dst, ui_) do { _Pragma("unroll") for (int _h = 0; _h < 2; ++_h) _Pragma("unroll") for (int _i = 0; _i < 2; ++_i) \
        dst[_h][_i] = (unsigned)gtab[(ui_) * 256 + _h * HALF + RA[_i]] * (unsigned)S.lda_bytes() + (unsigned)CA2[_i]; } while (0)
    const size_t kstep = (size_t)(BK * 2);
    const size_t hstep = (size_t)HALF * K * 2;
    const size_t tstep = 2 * hstep;
    const unsigned ldsw = (unsigned)wid * 1024u;
    const int aoff = lds_byte(wr * 64 + fr, fq * 8), boff = lds_byte(wc * 32 + fr, fq * 8);
#define PG8_SA(b, h) (((b) * 2 + (h)) * HTB)
#define PG8_SB(b, h) ((4 + (b) * 2 + (h)) * HTB)
#define PG8_STAGE(bufoff, gbase, voff) do { _Pragma("unroll") for (int _i = 0; _i < 2; ++_i) \
        __builtin_amdgcn_global_load_lds((const unsigned*)((const char*)(gbase) + (voff)[_i]), (PG8_LAS unsigned*)(lds + (bufoff) + ldsw + _i * 8192), 16, 0, 0); } while (0)
#define PG8_LDA(dst, b, h) do { _Pragma("unroll") for (int m = 0; m < 4; ++m) _Pragma("unroll") for (int k = 0; k < 2; ++k) dst[m][k] = *(const PG8_LAS bf16x8*)(lds + PG8_SA(b, h) + aoff + m * 2048 + k * 1024); } while (0)
#define PG8_LDB(dst, b, h) do { _Pragma("unroll") for (int n = 0; n < 2; ++n) _Pragma("unroll") for (int k = 0; k < 2; ++k) dst[n][k] = *(const PG8_LAS bf16x8*)(lds + PG8_SB(b, h) + boff + n * 2048 + k * 1024); } while (0)
#define PG8_MMA(ai, bj, At, Bt) do { __builtin_amdgcn_s_setprio(1); _Pragma("unroll") for (int m = 0; m < 4; ++m) _Pragma("unroll") for (int n = 0; n < 2; ++n) _Pragma("unroll") for (int k = 0; k < 2; ++k) \
        acc[ai][bj][m][n] = __builtin_amdgcn_mfma_f32_16x16x32_bf16(Bt[n][k], At[m][k], acc[ai][bj][m][n], 0, 0, 0); __builtin_amdgcn_s_setprio(0); } while (0)
#define PG8_WAIT_V(n) asm volatile("s_waitcnt vmcnt(" #n ")" ::: "memory")
#define PG8_WAIT_L(n) asm volatile("s_waitcnt lgkmcnt(" #n ")" ::: "memory")
#define PG8_BAR __builtin_amdgcn_s_barrier()
#define PG8_SCHED __builtin_amdgcn_sched_barrier(0)
    Unit cur, nxt; int ui = 0;
    if (!S.next(0, cur)) return;
    f32x4 acc[2][2][4][2];
#pragma unroll
    for (int a = 0; a < 2; ++a)
#pragma unroll
        for (int b = 0; b < 2; ++b)
#pragma unroll
            for (int m = 0; m < 4; ++m)
#pragma unroll
                for (int n = 0; n < 2; ++n) acc[a][b][m][n] = (f32x4){0.f, 0.f, 0.f, 0.f};
    bf16x8 At[4][2], B0[2][2], B1[2][2];
    const char* cA = (const char*)g.A + (GATHER ? (size_t)0 : (size_t)cur.pm * tstep); const char* cB = (const char*)g.Bt + (size_t)cur.pn * tstep;
    if constexpr (GATHER) {
        { Unit uu; for (int i = 0; S.next(i, uu); ++i) if (tid < 256) gtab[i * 256 + tid] = S.rowtab()[uu.pm * 256 + tid]; }
        asm volatile("s_waitcnt vmcnt(0) lgkmcnt(0)" ::: "memory"); __builtin_amdgcn_s_barrier(); asm volatile("" ::: "memory");
        PG8_GVOFF(vAc, 0);
    }
    S.a_ready(cur);
    if constexpr (SP2) {
        PG8_STAGE(PG8_SB(0, 0), cB, voffB); PG8_STAGE(PG8_SB(0, 1), cB + hstep, voffB); PG8_STAGE(PG8_SA(0, 0), cA, vAc[0]); PG8_STAGE(PG8_SA(0, 1), cA, vAc[1]);
        if (wr == 1) PG8_BAR;
        PG8_WAIT_V(2); PG8_BAR;
        PG8_STAGE(PG8_SB(1, 0), cB + kstep, voffB); PG8_STAGE(PG8_SA(1, 0), cA + kstep, vAc[0]); PG8_STAGE(PG8_SB(1, 1), cB + hstep + kstep, voffB);
        PG8_WAIT_V(6); PG8_BAR;
    } else {
        PG8_STAGE(PG8_SB(0, 0), cB, voffB); PG8_STAGE(PG8_SA(0, 0), cA, vAc[0]); PG8_STAGE(PG8_SB(0, 1), cB + hstep, voffB); PG8_STAGE(PG8_SA(0, 1), cA, vAc[1]);
        if (wr == 1) PG8_BAR;
        PG8_WAIT_V(4); PG8_BAR;
        PG8_STAGE(PG8_SB(1, 0), cB + kstep, voffB); PG8_STAGE(PG8_SA(1, 0), cA + kstep, vAc[0]); PG8_STAGE(PG8_SB(1, 1), cB + hstep + kstep, voffB);
        PG8_WAIT_V(6); PG8_BAR;
    }
    for (;;) {
        const bool has_next = S.next(ui + 1, nxt);
        const char* nA = has_next ? (const char*)g.A + (GATHER ? (size_t)0 : (size_t)nxt.pm * tstep) : cA; const char* nB = has_next ? (const char*)g.Bt + (size_t)nxt.pn * tstep : cB;
        if constexpr (GATHER) { if (has_next) PG8_GVOFF(vAn, ui + 1); else { _Pragma("unroll") for (int _h = 0; _h < 2; ++_h) _Pragma("unroll") for (int _i = 0; _i < 2; ++_i) vAn[_h][_i] = vAc[_h][_i]; } }
        for (int seg = 0; seg < (Epi::MIDK > 0 ? 2 : 1); ++seg) {
        const int t_lo = (Epi::MIDK > 0 && seg == 1) ? Epi::MIDK : 0, t_hi = (Epi::MIDK > 0 && seg == 0) ? Epi::MIDK : nt;
        if constexpr (Epi::MIDK > 0) { if (seg == 1) E.mid(acc, cur, wr, wc, fr, fq); }
        for (int t = t_lo; t < t_hi; t += 2) {
            const bool last = (t == nt - 2);
            unsigned vAl[2][2];
#pragma unroll
            for (int _h = 0; _h < 2; ++_h)
#pragma unroll
                for (int _i = 0; _i < 2; ++_i) vAl[_h][_i] = (GATHER && last) ? vAn[_h][_i] : vAc[_h][_i];
            const char* a1 = cA + (size_t)(t + 1) * kstep;
            const char* a2 = last ? nA : cA + (size_t)(t + 2) * kstep; const char* b2 = last ? nB : cB + (size_t)(t + 2) * kstep;
            const char* a3 = a2 + kstep; const char* b3 = b2 + kstep;
            if (last && has_next) S.a_ready(nxt);
            if constexpr (SP2) {
            PG8_LDB(B0, 0, 0); PG8_LDB(B1, 0, 1); PG8_SCHED; PG8_LDA(At, 0, 0); PG8_STAGE(PG8_SA(1, 1), a1, vAc[1]);
            PG8_WAIT_V(8); PG8_WAIT_L(0); PG8_BAR; PG8_MMA(0, 0, At, B0); PG8_MMA(0, 1, At, B1); PG8_BAR; PG8_SCHED;
            PG8_LDA(At, 0, 1); PG8_STAGE(PG8_SB(0, 0), b2, voffB); PG8_STAGE(PG8_SB(0, 1), b2 + hstep, voffB); PG8_STAGE(PG8_SA(0, 0), a2, vAl[0]);
            PG8_WAIT_V(8); PG8_WAIT_L(0); PG8_BAR; PG8_MMA(1, 0, At, B0); PG8_MMA(1, 1, At, B1); PG8_BAR; PG8_SCHED;
            PG8_LDB(B0, 1, 0); PG8_LDB(B1, 1, 1); PG8_SCHED; PG8_LDA(At, 1, 0); PG8_STAGE(PG8_SA(0, 1), a2, vAl[1]);
            PG8_WAIT_V(8); PG8_WAIT_L(0); PG8_BAR; PG8_MMA(0, 0, At, B0); PG8_MMA(0, 1, At, B1); PG8_BAR; PG8_SCHED;
            PG8_LDA(At, 1, 1); PG8_STAGE(PG8_SB(1, 0), b3, voffB); PG8_STAGE(PG8_SB(1, 1), b3 + hstep, voffB); PG8_STAGE(PG8_SA(1, 0), a3, vAl[0]);
            PG8_WAIT_V(8); PG8_WAIT_L(0); PG8_BAR; PG8_MMA(1, 0, At, B0); PG8_MMA(1, 1, At, B1); PG8_BAR; PG8_SCHED;
            } else {
            PG8_LDB(B0, 0, 0); PG8_SCHED; PG8_LDA(At, 0, 0); PG8_STAGE(PG8_SA(1, 1), a1, vAc[1]);
            PG8_WAIT_L(8); PG8_BAR; PG8_WAIT_L(0); PG8_MMA(0, 0, At, B0); PG8_BAR; PG8_SCHED;
            PG8_LDB(B1, 0, 1); PG8_STAGE(PG8_SB(0, 0), b2, voffB);
            PG8_BAR; PG8_WAIT_L(0); PG8_MMA(0, 1, At, B1); PG8_BAR;
            PG8_LDA(At, 0, 1); PG8_STAGE(PG8_SA(0, 0), a2, vAl[0]);
            PG8_BAR; PG8_WAIT_L(0); PG8_MMA(1, 0, At, B0); PG8_BAR; PG8_SCHED;
            PG8_STAGE(PG8_SB(0, 1), b2 + hstep, voffB);
            PG8_WAIT_V(6); PG8_BAR; PG8_MMA(1, 1, At, B1); PG8_BAR;
            PG8_LDB(B0, 1, 0); PG8_SCHED; PG8_LDA(At, 1, 0); PG8_STAGE(PG8_SA(0, 1), a2, vAl[1]);
            PG8_WAIT_L(8); PG8_BAR; PG8_WAIT_L(0); PG8_MMA(0, 0, At, B0); PG8_BAR; PG8_SCHED;
            PG8_LDB(B1, 1, 1); PG8_STAGE(PG8_SB(1, 0), b3, voffB);
            PG8_BAR; PG8_WAIT_L(0); PG8_MMA(0, 1, At, B1); PG8_BAR;
            PG8_LDA(At, 1, 1); PG8_STAGE(PG8_SA(1, 0), a3, vAl[0]);
            PG8_BAR; PG8_WAIT_L(0); PG8_MMA(1, 0, At, B0); PG8_BAR; PG8_SCHED;
            PG8_STAGE(PG8_SB(1, 1), b3 + hstep, voffB);
            PG8_WAIT_V(6); PG8_BAR; PG8_MMA(1, 1, At, B1); PG8_BAR;
            }
        }
        }
        if constexpr (ALIGN_EPI) { if (wr == 0) PG8_BAR; }
        if constexpr (!Epi::AFTER_DRAIN) { E(acc, cur, wr, wc, fr, fq); S.done(cur); }
        if (!has_next) break;
#pragma unroll
        for (int a = 0; a < 2; ++a)
#pragma unroll
            for (int b = 0; b < 2; ++b)
#pragma unroll
                for (int m = 0; m < 4; ++m)
#pragma unroll
                    for (int n = 0; n < 2; ++n) acc[a][b][m][n] = (f32x4){0.f, 0.f, 0.f, 0.f};
        cur = nxt; cA = nA; cB = nB; ++ui;
        if constexpr (GATHER) { _Pragma("unroll") for (int _h = 0; _h < 2; ++_h) _Pragma("unroll") for (int _i = 0; _i < 2; ++_i) vAc[_h][_i] = vAn[_h][_i]; }
        if constexpr (ALIGN_EPI) { if (wr == 1) PG8_BAR; }
    }
    PG8_WAIT_V(0);
    if constexpr (!ALIGN_EPI) { if (wr == 0) PG8_BAR; }
    PG8_BAR;
    if constexpr (Epi::AFTER_DRAIN) { E.fused(acc, cur, wr, wc, fr, fq, lds, wid, lane); S.done(cur); }
#undef PG8_SA
#undef PG8_SB
#undef PG8_STAGE
#undef PG8_GVOFF
#undef PG8_LDA
#undef PG8_LDB
#undef PG8_MMA
#undef PG8_WAIT_V
#undef PG8_WAIT_L
#undef PG8_BAR
#undef PG8_SCHED
}
}

namespace attn {
constexpr int D = 128, NW = 8, QBLK = 32, KVBLK = 64;
constexpr float SCALE = 0.088388347648318440f;
constexpr float THR = 8.f;
constexpr int LDQ = 1024, LDK = 256, LDO = 1536;
constexpr size_t SHM_V = KVBLK * D * 2, SHM_K = KVBLK * D * 2, SHM_ATTN = 3 * SHM_V + 3 * SHM_K + NW * 64 * 4;
typedef unsigned short bf16;
using bf16x8 = __attribute__((ext_vector_type(8))) short;
using s16x4  = __attribute__((ext_vector_type(4))) short;
using f32x16 = __attribute__((ext_vector_type(16))) float;
using u32x4  = __attribute__((ext_vector_type(4))) unsigned;
#define KSWZ(row, colB) ((row) * 256 + ((colB) ^ (((row) & 7) << 4)))
#define SBAR() __builtin_amdgcn_sched_barrier(0)
__device__ __forceinline__ int crow(int r, int hi) { return (r & 3) + 8 * (r >> 2) + 4 * hi; }
__device__ __forceinline__ unsigned cvtpk(float lo, float hi) { unsigned r; asm volatile("v_cvt_pk_bf16_f32 %0, %1, %2" : "=v"(r) : "v"(lo), "v"(hi)); return r; }
constexpr float THR2 = THR * 1.4426950408889634f;
__device__ __forceinline__ float bf16r(float x) { const unsigned u = __float_as_uint(x); return __uint_as_float((u + 0x7fffu + ((u >> 16) & 1u)) & 0xffff0000u); }
__device__ __forceinline__ void partialSM(f32x16& p0, f32x16& p1, float& mb, bool first, float& alpha, f32x16* o, float* al_l, int r32, int hi) {
  float pmax = p0[0]; for (int r = 1; r < 16; ++r) pmax = fmaxf(pmax, p0[r]); for (int r = 0; r < 16; ++r) pmax = fmaxf(pmax, p1[r]);
  { auto rr = __builtin_amdgcn_permlane32_swap(__float_as_uint(pmax), __float_as_uint(pmax), false, false);
    pmax = fmaxf(__uint_as_float(rr[0]), __uint_as_float(rr[1])); }
  if (__builtin_expect(!first && __all(pmax <= THR2), 1)) { alpha = 1.f; }
  else { const float mbn = bf16r(mb + (first ? pmax : fmaxf(pmax, 0.f))), dl = mbn - mb; alpha = first ? 1.f : __builtin_amdgcn_exp2f(-dl); mb = mbn;
    for (int r = 0; r < 16; ++r) p0[r] -= dl; for (int r = 0; r < 16; ++r) p1[r] -= dl;
    if (!first) {
      if (hi == 0) al_l[r32] = alpha; asm volatile("s_waitcnt lgkmcnt(0)" ::: "memory");
      for (int d = 0; d < 4; ++d) for (int r = 0; r < 16; ++r) o[d][r] *= al_l[crow(r, hi)]; } }
  for (int r = 0; r < 16; ++r) p0[r] = __builtin_amdgcn_exp2f(p0[r]);
}
__device__ __forceinline__ void finishSM(f32x16& p0, f32x16& p1, float alpha, float& l_reg, bf16x8& pa0, bf16x8& pa1, bf16x8& pa2, bf16x8& pa3) {
  for (int r = 0; r < 16; ++r) p1[r] = __builtin_amdgcn_exp2f(p1[r]);
  float ps = 0; for (int r = 0; r < 16; ++r) ps += p0[r]; for (int r = 0; r < 16; ++r) ps += p1[r];
  { auto rr = __builtin_amdgcn_permlane32_swap(__float_as_uint(ps), __float_as_uint(ps), false, false);
    ps = __uint_as_float(rr[0]) + __uint_as_float(rr[1]); }
  l_reg = l_reg * alpha + ps;
#define PK4(P, BASE, OUT) do { u32x4 w = {cvtpk(P[BASE + 0], P[BASE + 1]), cvtpk(P[BASE + 2], P[BASE + 3]), cvtpk(P[BASE + 4], P[BASE + 5]), cvtpk(P[BASE + 6], P[BASE + 7])}; OUT = *reinterpret_cast<bf16x8*>(&w); } while (0)
  PK4(p0, 0, pa0); PK4(p0, 8, pa1); PK4(p1, 0, pa2); PK4(p1, 8, pa3);
#undef PK4
}
__device__ __forceinline__ void qkt(f32x16& p0, f32x16& p1, const bf16* Ks, const bf16x8* qr, int r32, int hi) {
  p0 = f32x16{}; p1 = f32x16{};
  for (int d0 = 0; d0 < 8; ++d0) { int cb = (d0 * 16 + hi * 8) * 2;
    bf16x8 b0 = *reinterpret_cast<const bf16x8*>((const char*)Ks + KSWZ(r32, cb));
    bf16x8 b1 = *reinterpret_cast<const bf16x8*>((const char*)Ks + KSWZ(32 + r32, cb));
    p0 = __builtin_amdgcn_mfma_f32_32x32x16_bf16(b0, qr[d0], p0, 0, 0, 0);
    p1 = __builtin_amdgcn_mfma_f32_32x32x16_bf16(b1, qr[d0], p1, 0, 0, 0); }
}
__device__ __forceinline__ int v_st(int k, int c) { const int kk = (k & ~0xC) | ((k & 4) << 1) | ((k & 8) >> 1); return ((kk >> 3) * 4 + (c >> 5)) * 512 + ((kk & 7) * 32 + (c & 31)) * 2; }
__device__ __forceinline__ int v_rd_base(int lane) { return ((lane & 3) << 3) | (((lane >> 2) & 3) << 6) | (((lane >> 4) & 1) << 5) | (((lane >> 5) & 1) << 8); }
constexpr int v_rd_off(int d0, int ks, int half) { return d0 * 512 + ks * 4096 + half * 2048; }
template <int OFF> __device__ __forceinline__ s16x4 tr_read(int vb) {
  s16x4 r; asm volatile("ds_read_b64_tr_b16 %0, %1 offset:%2" : "=&v"(r) : "v"(vb), "i"(OFF) : "memory"); return r;
}
template <int D0> __device__ __forceinline__ void pv_one(f32x16& od, int vb, bf16x8 pa0, bf16x8 pa1, bf16x8 pa2, bf16x8 pa3) {
  const s16x4 l0 = tr_read<v_rd_off(D0, 0, 0)>(vb), h0 = tr_read<v_rd_off(D0, 0, 1)>(vb), l1 = tr_read<v_rd_off(D0, 1, 0)>(vb), h1 = tr_read<v_rd_off(D0, 1, 1)>(vb);
  const s16x4 l2 = tr_read<v_rd_off(D0, 2, 0)>(vb), h2 = tr_read<v_rd_off(D0, 2, 1)>(vb), l3 = tr_read<v_rd_off(D0, 3, 0)>(vb), h3 = tr_read<v_rd_off(D0, 3, 1)>(vb);
  asm volatile("s_waitcnt lgkmcnt(0)" ::: "memory"); SBAR();
#define PK(L, H) (bf16x8){L[0], L[1], L[2], L[3], H[0], H[1], H[2], H[3]}
  od = __builtin_amdgcn_mfma_f32_32x32x16_bf16(pa0, PK(l0, h0), od, 0, 0, 0);
  od = __builtin_amdgcn_mfma_f32_32x32x16_bf16(pa1, PK(l1, h1), od, 0, 0, 0);
  od = __builtin_amdgcn_mfma_f32_32x32x16_bf16(pa2, PK(l2, h2), od, 0, 0, 0);
  od = __builtin_amdgcn_mfma_f32_32x32x16_bf16(pa3, PK(l3, h3), od, 0, 0, 0);
#undef PK
}
__device__ __forceinline__ void pv_d0(f32x16* o, int vb, bf16x8 pa0, bf16x8 pa1, bf16x8 pa2, bf16x8 pa3) {
  pv_one<0>(o[0], vb, pa0, pa1, pa2, pa3); pv_one<1>(o[1], vb, pa0, pa1, pa2, pa3); pv_one<2>(o[2], vb, pa0, pa1, pa2, pa3); pv_one<3>(o[3], vb, pa0, pa1, pa2, pa3);
}
__device__ __forceinline__ void mstage(f32x16* o, f32x16& p0, f32x16& p1, int vb, int kb0, int kb1, int kb2, int kb3, const bf16x8* qr, bf16x8 pa0, bf16x8 pa1, bf16x8 pa2, bf16x8 pa3, bf16x8 kx, bf16x8 qx) {
  asm volatile(
    "s_nop 4\n\t"
    "ds_read_b128 v[200:203], %[kb0] offset:0\n\t"
    "ds_read_b128 v[204:207], %[kb0] offset:8192\n\t"
    "ds_read_b64_tr_b16 v[208:209], %[vb] offset:0\n\t"
    "ds_read_b64_tr_b16 v[210:211], %[vb] offset:2048\n\t"
    "ds_read_b64_tr_b16 v[212:213], %[vb] offset:4096\n\t"
    "ds_read_b64_tr_b16 v[214:215], %[vb] offset:6144\n\t"
    "ds_read_b128 v[216:219], %[kb1] offset:0\n\t"
    "ds_read_b128 v[220:223], %[kb1] offset:8192\n\t"
    "v_mfma_f32_32x32x16_bf16 %[p0], %[kx], %[qx], 0\n\t"
    "v_mfma_f32_32x32x16_bf16 %[p1], %[kx], %[qx], 0\n\t"
    "s_waitcnt lgkmcnt(6)\n\t"
    "v_mfma_f32_32x32x16_bf16 %[p0], v[200:203], %[q0], %[p0]\n\t"
    "v_mfma_f32_32x32x16_bf16 %[p1], v[204:207], %[q0], %[p1]\n\t"
    "ds_read_b64_tr_b16 v[200:201], %[vb] offset:8192\n\t"
    "ds_read_b64_tr_b16 v[202:203], %[vb] offset:10240\n\t"
    "ds_read_b64_tr_b16 v[204:205], %[vb] offset:12288\n\t"
    "ds_read_b64_tr_b16 v[206:207], %[vb] offset:14336\n\t"
    "s_waitcnt lgkmcnt(6)\n\t"
    "v_mfma_f32_32x32x16_bf16 %[o0], %[a0], v[208:211], %[o0]\n\t"
    "v_mfma_f32_32x32x16_bf16 %[o0], %[a1], v[212:215], %[o0]\n\t"
    "ds_read_b128 v[208:211], %[kb2] offset:0\n\t"
    "ds_read_b128 v[212:215], %[kb2] offset:8192\n\t"
    "s_waitcnt lgkmcnt(6)\n\t"
    "v_mfma_f32_32x32x16_bf16 %[p0], v[216:219], %[q1], %[p0]\n\t"
    "v_mfma_f32_32x32x16_bf16 %[p1], v[220:223], %[q1], %[p1]\n\t"
    "ds_read_b64_tr_b16 v[216:217], %[vb] offset:512\n\t"
    "ds_read_b64_tr_b16 v[218:219], %[vb] offset:2560\n\t"
    "ds_read_b64_tr_b16 v[220:221], %[vb] offset:4608\n\t"
    "ds_read_b64_tr_b16 v[222:223], %[vb] offset:6656\n\t"
    "s_waitcnt lgkmcnt(6)\n\t"
    "v_mfma_f32_32x32x16_bf16 %[o0], %[a2], v[200:203], %[o0]\n\t"
    "v_mfma_f32_32x32x16_bf16 %[o0], %[a3], v[204:207], %[o0]\n\t"
    "ds_read_b128 v[200:203], %[kb3] offset:0\n\t"
    "ds_read_b128 v[204:207], %[kb3] offset:8192\n\t"
    "s_waitcnt lgkmcnt(6)\n\t"
    "v_mfma_f32_32x32x16_bf16 %[p0], v[208:211], %[q2], %[p0]\n\t"
    "v_mfma_f32_32x32x16_bf16 %[p1], v[212:215], %[q2], %[p1]\n\t"
    "ds_read_b64_tr_b16 v[208:209], %[vb] offset:8704\n\t"
    "ds_read_b64_tr_b16 v[210:211], %[vb] offset:10752\n\t"
    "ds_read_b64_tr_b16 v[212:213], %[vb] offset:12800\n\t"
    "ds_read_b64_tr_b16 v[214:215], %[vb] offset:14848\n\t"
    "s_waitcnt lgkmcnt(6)\n\t"
    "v_mfma_f32_32x32x16_bf16 %[o1], %[a0], v[216:219], %[o1]\n\t"
    "v_mfma_f32_32x32x16_bf16 %[o1], %[a1], v[220:223], %[o1]\n\t"
    "ds_read_b128 v[216:219], %[kb0] offset:128\n\t"
    "ds_read_b128 v[220:223], %[kb0] offset:8320\n\t"
    "s_waitcnt lgkmcnt(6)\n\t"
    "v_mfma_f32_32x32x16_bf16 %[p0], v[200:203], %[q3], %[p0]\n\t"
    "v_mfma_f32_32x32x16_bf16 %[p1], v[204:207], %[q3], %[p1]\n\t"
    "ds_read_b64_tr_b16 v[200:201], %[vb] offset:1024\n\t"
    "ds_read_b64_tr_b16 v[202:203], %[vb] offset:3072\n\t"
    "ds_read_b64_tr_b16 v[204:205], %[vb] offset:5120\n\t"
    "ds_read_b64_tr_b16 v[206:207], %[vb] offset:7168\n\t"
    "s_waitcnt lgkmcnt(6)\n\t"
    "v_mfma_f32_32x32x16_bf16 %[o1], %[a2], v[208:211], %[o1]\n\t"
    "v_mfma_f32_32x32x16_bf16 %[o1], %[a3], v[212:215], %[o1]\n\t"
    "ds_read_b128 v[208:211], %[kb1] offset:128\n\t"
    "ds_read_b128 v[212:215], %[kb1] offset:8320\n\t"
    "s_waitcnt lgkmcnt(6)\n\t"
    "v_mfma_f32_32x32x16_bf16 %[p0], v[216:219], %[q4], %[p0]\n\t"
    "v_mfma_f32_32x32x16_bf16 %[p1], v[220:223], %[q4], %[p1]\n\t"
    "ds_read_b64_tr_b16 v[216:217], %[vb] offset:9216\n\t"
    "ds_read_b64_tr_b16 v[218:219], %[vb] offset:11264\n\t"
    "ds_read_b64_tr_b16 v[220:221], %[vb] offset:13312\n\t"
    "ds_read_b64_tr_b16 v[222:223], %[vb] offset:15360\n\t"
    "s_waitcnt lgkmcnt(6)\n\t"
    "v_mfma_f32_32x32x16_bf16 %[o2], %[a0], v[200:203], %[o2]\n\t"
    "v_mfma_f32_32x32x16_bf16 %[o2], %[a1], v[204:207], %[o2]\n\t"
    "ds_read_b128 v[200:203], %[kb2] offset:128\n\t"
    "ds_read_b128 v[204:207], %[kb2] offset:8320\n\t"
    "s_waitcnt lgkmcnt(6)\n\t"
    "v_mfma_f32_32x32x16_bf16 %[p0], v[208:211], %[q5], %[p0]\n\t"
    "v_mfma_f32_32x32x16_bf16 %[p1], v[212:215], %[q5], %[p1]\n\t"
    "ds_read_b64_tr_b16 v[208:209], %[vb] offset:1536\n\t"
    "ds_read_b64_tr_b16 v[210:211], %[vb] offset:3584\n\t"
    "ds_read_b64_tr_b16 v[212:213], %[vb] offset:5632\n\t"
    "ds_read_b64_tr_b16 v[214:215], %[vb] offset:7680\n\t"
    "s_waitcnt lgkmcnt(6)\n\t"
    "v_mfma_f32_32x32x16_bf16 %[o2], %[a2], v[216:219], %[o2]\n\t"
    "v_mfma_f32_32x32x16_bf16 %[o2], %[a3], v[220:223], %[o2]\n\t"
    "ds_read_b128 v[216:219], %[kb3] offset:128\n\t"
    "ds_read_b128 v[220:223], %[kb3] offset:8320\n\t"
    "s_waitcnt lgkmcnt(6)\n\t"
    "v_mfma_f32_32x32x16_bf16 %[p0], v[200:203], %[q6], %[p0]\n\t"
    "v_mfma_f32_32x32x16_bf16 %[p1], v[204:207], %[q6], %[p1]\n\t"
    "ds_read_b64_tr_b16 v[200:201], %[vb] offset:9728\n\t"
    "ds_read_b64_tr_b16 v[202:203], %[vb] offset:11776\n\t"
    "ds_read_b64_tr_b16 v[204:205], %[vb] offset:13824\n\t"
    "ds_read_b64_tr_b16 v[206:207], %[vb] offset:15872\n\t"
    "s_waitcnt lgkmcnt(6)\n\t"
    "v_mfma_f32_32x32x16_bf16 %[o3], %[a0], v[208:211], %[o3]\n\t"
    "v_mfma_f32_32x32x16_bf16 %[o3], %[a1], v[212:215], %[o3]\n\t"
    "s_waitcnt lgkmcnt(4)\n\t"
    "v_mfma_f32_32x32x16_bf16 %[p0], v[216:219], %[q7], %[p0]\n\t"
    "v_mfma_f32_32x32x16_bf16 %[p1], v[220:223], %[q7], %[p1]\n\t"
    "s_waitcnt lgkmcnt(0)\n\t"
    "v_mfma_f32_32x32x16_bf16 %[o3], %[a2], v[200:203], %[o3]\n\t"
    "v_mfma_f32_32x32x16_bf16 %[o3], %[a3], v[204:207], %[o3]\n\t"
    "s_nop 15\n\t"
    "s_nop 7\n\t"
    : [o0] "+v"(o[0]), [o1] "+v"(o[1]), [o2] "+v"(o[2]), [o3] "+v"(o[3]), [p0] "=&v"(p0), [p1] "=&v"(p1)
    : [q0] "v"(qr[0]), [q1] "v"(qr[1]), [q2] "v"(qr[2]), [q3] "v"(qr[3]), [q4] "v"(qr[4]), [q5] "v"(qr[5]), [q6] "v"(qr[6]), [q7] "v"(qr[7]),
      [a0] "v"(pa0), [a1] "v"(pa1), [a2] "v"(pa2), [a3] "v"(pa3), [vb] "v"(vb), [kb0] "v"(kb0), [kb1] "v"(kb1), [kb2] "v"(kb2), [kb3] "v"(kb3), [kx] "v"(kx), [qx] "v"(qx)
    : "memory", "v200", "v201", "v202", "v203", "v204", "v205", "v206", "v207", "v208", "v209", "v210", "v211", "v212", "v213", "v214", "v215", "v216", "v217", "v218", "v219", "v220", "v221", "v222", "v223");
}
__device__ __forceinline__ void attn_dense_body(const bf16* __restrict__ Qb, bf16* __restrict__ Ob, const bf16* __restrict__ Kh, const bf16* __restrict__ Vh, int seq, char* lds,
                                                const float* __restrict__ qnw, const float2* __restrict__ rope, int pos0, int wave_s) {
  int tid; asm volatile("v_mbcnt_lo_u32_b32 %0, -1, 0\n\tv_mbcnt_hi_u32_b32 %0, -1, %0\n\tv_lshl_or_b32 %0, %1, 6, %0" : "=&v"(tid) : "s"(wave_s));
  const int wid = tid >> 6, lane = tid & 63, r32 = lane & 31, hi = lane >> 5, wu = __builtin_amdgcn_readfirstlane(tid >> 6);
  bf16* V_lds = (bf16*)lds; bf16* K_lds = (bf16*)(lds + 3 * SHM_V);
  float* ws = (float*)(lds + 3 * SHM_V + 3 * SHM_K) + wu * 64; float* li_l = ws; float* al_l = ws + 32;
  float mb = 0.f, l_reg = 0; f32x16 o[4] = {}; bf16x8 qr[8];
  const bf16* Qw = Qb + (long)(wu * QBLK + r32) * LDQ + hi * 8;
  {
    u32x4 raw[8]; float ss = 0.f;
#pragma unroll
    for (int d0 = 0; d0 < 8; ++d0) { raw[d0] = *reinterpret_cast<const u32x4*>(Qw + d0 * 16);
#pragma unroll
      for (int i = 0; i < 4; ++i) { const float a = __uint_as_float(raw[d0][i] << 16), b = __uint_as_float(raw[d0][i] & 0xffff0000u); ss += a * a + b * b; } }
    { auto rr = __builtin_amdgcn_permlane32_swap(__float_as_uint(ss), __float_as_uint(ss), false, false); ss = __uint_as_float(rr[0]) + __uint_as_float(rr[1]); }
    const float rstd = rsqrtf(ss * (1.f / 128.f) + 1e-6f) * (SCALE * 1.4426950408889634f);
    const int pos = pos0 + wu * QBLK + r32;
#pragma unroll
    for (int d0 = 0; d0 < 4; ++d0) {
      float fa[8], fb[8];
      const float* wa = qnw + d0 * 16 + hi * 8; const float* wb = wa + 64;
#pragma unroll
      for (int i = 0; i < 4; ++i) { fa[2 * i] = __uint_as_float(raw[d0][i] << 16) * rstd * wa[2 * i]; fa[2 * i + 1] = __uint_as_float(raw[d0][i] & 0xffff0000u) * rstd * wa[2 * i + 1];
        fb[2 * i] = __uint_as_float(raw[d0 + 4][i] << 16) * rstd * wb[2 * i]; fb[2 * i + 1] = __uint_as_float(raw[d0 + 4][i] & 0xffff0000u) * rstd * wb[2 * i + 1]; }
      if (rope) { const int j0 = d0 * 16 + hi * 8;
        const float2* tp = (d0 < 2) ? rope + (pos >> 6) * 32 + j0 : rope + (pos & 63) * 32 + (j0 - 32);
#pragma unroll
        for (int i = 0; i < 8; ++i) { const float2 cs = tp[i]; const float a = fa[i], b = fb[i]; fa[i] = a * cs.x - b * cs.y; fb[i] = a * cs.y + b * cs.x; } }
      { u32x4 w = {cvtpk(fa[0], fa[1]), cvtpk(fa[2], fa[3]), cvtpk(fa[4], fa[5]), cvtpk(fa[6], fa[7])}; qr[d0] = *reinterpret_cast<bf16x8*>(&w); }
      { u32x4 w = {cvtpk(fb[0], fb[1]), cvtpk(fb[2], fb[3]), cvtpk(fb[4], fb[5]), cvtpk(fb[6], fb[7])}; qr[d0 + 4] = *reinterpret_cast<bf16x8*>(&w); }
    }
  }
  const int vb0 = (int)(uintptr_t)V_lds + v_rd_base(lane);
  unsigned koff, voff;
  { const int krow = 4 * wu + (lane >> 4); koff = (unsigned)(krow * (LDK * 2) + (((lane & 15) ^ (krow & 7)) << 4));
    const int blk = 2 * wu + (lane >> 5), kk = (blk >> 2) * 8 + ((lane & 31) >> 2), kx = kk  , cc = (blk & 3) * 32 + (lane & 3) * 8;
    voff = (unsigned)(kx * (LDK * 2) + cc * 2); }
  typedef __attribute__((address_space(3))) unsigned lds_u32;
#define DMA2(gbase, off, ldsbase) do { const char* g_ = (const char*)(gbase) + (off); \
    __builtin_amdgcn_global_load_lds((const unsigned*)g_, (lds_u32*)(unsigned)(uintptr_t)((ldsbase) + wu * 1024), 16, 0, 0); \
    __builtin_amdgcn_global_load_lds((const unsigned*)(g_ + 32 * LDK * 2), (lds_u32*)(unsigned)(uintptr_t)((ldsbase) + 8192 + wu * 1024), 16, 0, 0); } while (0)
#define LOADK(t, b) DMA2((const char*)Kh + (long)(t) * (KVBLK * LDK * 2), koff, (char*)K_lds + (b) * SHM_K)
#define LOADV(t, b) DMA2((const char*)Vh + (long)(t) * (KVBLK * LDK * 2), voff, (char*)V_lds + (b) * SHM_V)
#define VMWAIT() asm volatile("s_waitcnt vmcnt(0)" ::: "memory")
#define WGBAR() asm volatile("s_waitcnt lgkmcnt(0)\n\ts_barrier" ::: "memory")
#define SOFTMAX_(first) do { float al_; partialSM(p0, p1, mb, first, al_, o, al_l, r32, hi); finishSM(p0, p1, al_, l_reg, pa0, pa1, pa2, pa3); } while (0)
#define SOFTMAX() do { __builtin_amdgcn_s_setprio(1); SOFTMAX_(false); __builtin_amdgcn_s_setprio(0); } while (0)
#define QX() ({ u32x4 w_ = {hi == 0 ? (__float_as_uint(mb) >> 16) : 0u, 0u, 0u, 0u}; *reinterpret_cast<bf16x8*>(&w_); })
#define VMWAIT4() asm volatile("s_waitcnt vmcnt(4)" ::: "memory")
#define STAGE(k, s0, s2) do { LOADK(min((k) + 3, NT - 1), s0); LOADV(min((k) + 2, NT - 1), s2); } while (0)
  int mvb, mk0, mk1, mk2, mk3; bf16x8 mqx;
#define MPREP(sv, sk) do { const int ko_ = (int)((sk) * SHM_K); mvb = vb0 + (int)((sv) * SHM_V); mk0 = kbase + ko_; mk1 = (kbase ^ 32) + ko_; mk2 = (kbase ^ 64) + ko_; mk3 = (kbase ^ 96) + ko_; mqx = QX(); \
    asm volatile("" : "+v"(mvb), "+v"(mk0), "+v"(mk1), "+v"(mk2), "+v"(mk3), "+v"(mqx)); } while (0)
#define MSTAGE() mstage(o, p0, p1, mvb, mk0, mk1, mk2, mk3, qr, pa0, pa1, pa2, pa3, kx, mqx)
#define MLAST() pv_d0(o, mvb, pa0, pa1, pa2, pa3)
  f32x16 p0, p1; bf16x8 pa0, pa1, pa2, pa3; const int NT = seq / KVBLK;
  const int kbase = (int)(uintptr_t)K_lds + KSWZ(r32, hi * 16);
  LOADK(0, 0); LOADV(0, 0); LOADK(1, 1); LOADV(min(1, NT - 1), 1); LOADK(min(2, NT - 1), 2); VMWAIT(); WGBAR();
  qkt(p0, p1, K_lds, qr, r32, hi); SOFTMAX_(true);
  bf16x8 kx; { u32x4 w_ = {hi == 0 ? 0x0000BF80u : 0u, 0u, 0u, 0u}; kx = *reinterpret_cast<bf16x8*>(&w_); }
  MPREP(0, 1); WGBAR();
  if (wid < 4) {
    int s0 = 0, s1 = 1, s2 = 2;
#pragma unroll 1
    for (int k = 0; k < NT - 1; ++k) {
      MSTAGE(); WGBAR();
      __builtin_amdgcn_s_setprio(1); STAGE(k, s0, s2); SOFTMAX_(false);
      { const int t_ = s0; s0 = s1; s1 = s2; s2 = t_; }
      MPREP(s0, s1); __builtin_amdgcn_s_setprio(0);
      VMWAIT4(); WGBAR();
    }
    MLAST(); WGBAR();
    WGBAR();
  } else {
    int s0 = 0, s1 = 1, s2 = 2;
    STAGE(0, s0, s2); WGBAR();
#pragma unroll 1
    for (int k = 0; k < NT - 1; ++k) {
      MSTAGE(); VMWAIT4(); WGBAR();
      { const int t_ = s0; s0 = s1; s1 = s2; s2 = t_; }
      __builtin_amdgcn_s_setprio(1); if (k + 1 < NT - 1) STAGE(k + 1, s0, s2);
      SOFTMAX_(false); MPREP(s0, s1); __builtin_amdgcn_s_setprio(0);
      WGBAR();
    }
    MLAST(); WGBAR();
  }
  VMWAIT();
  if (hi == 0) li_l[r32] = l_reg; asm volatile("s_waitcnt lgkmcnt(0)" ::: "memory");
  float rli[16];
#pragma unroll
  for (int r = 0; r < 16; ++r) rli[r] = __builtin_amdgcn_rcpf(li_l[crow(r, hi)]);
  bf16* Ow = Ob + (long)(wu * QBLK) * LDO;
#pragma unroll
  for (int r = 0; r < 16; ++r) { int orow = crow(r, hi);
    for (int d0 = 0; d0 < 4; ++d0) Ow[(long)orow * LDO + d0 * 32 + r32] = (bf16)(cvtpk(o[d0][r] * rli[r], 0.f) & 0xffffu); }
  __syncthreads();
#undef LD8
#undef LOADK
#undef LOADV
#undef DMA2
#undef VMWAIT
#undef WGBAR
#undef SOFTMAX
#undef SOFTMAX_
#undef QX
#undef STAGE
#undef VMWAIT4
#undef MSTAGE
#undef MLAST
}
#undef KSWZ
#undef SBAR
}

constexpr int NWAVES = 8, NTHR = 512;
constexpr int NB = 8, SEQ = 4096, DM = 1024, CL = 256, T_LAT = NB * SEQ, T_CTX = NB * CL, R_ALL = T_LAT + T_CTX;
constexpr int SKV = SEQ + CL;
constexpr int NH = 8, NKV = 2, HD = 128;
constexpr int HYW = 512, NE = 64, EDIM = 512;
constexpr int INW = 5120, NA_COLS = 3584, NU_COLS = 1536;
constexpr int NSLOT_MAX = 86016;
constexpr float EPS = 1e-6f;
enum { I_X = 0, I_C, I_CTX, I_CCTX, I_WADA, I_BADA, I_N1W, I_N2W, I_WIN, I_QNW, I_KNW, I_HCW, I_HCB, I_PW1, I_PB1, I_PF1, I_PW2, I_PB2, I_PF2, I_PW3, I_SKIP,
       I_WAP, I_WHP, I_WOUT, I_RW, I_RB, I_EW1, I_EW3, I_EW2, I_FNW, N_IN };
constexpr size_t MiB = 1u << 20;
constexpr size_t WS_CTL = 0, CTL_ZERO_BYTES = 1 * MiB;
constexpr size_t WS_MODP = 1 * MiB;
constexpr size_t WS_MODS = 8 * MiB;
constexpr size_t WS_ROPE = WS_MODS + 512 * 1024;
constexpr size_t WS_H2 = 9 * MiB;
constexpr size_t WS_HIST = 12 * MiB;
constexpr size_t WS_TOKE = WS_HIST + 65536;
constexpr size_t WS_TOKG = WS_TOKE + (size_t)R_ALL * 8;
constexpr size_t WS_TOKR = WS_TOKG + (size_t)R_ALL * 8;
constexpr size_t WS_TOKS = WS_TOKR + (size_t)R_ALL * 8;
constexpr size_t WS_BLKE = WS_TOKS + (size_t)R_ALL * 8;
static_assert(WS_BLKE + 4096 <= 14 * MiB, "misc region");
constexpr size_t WS_STOK = 14 * MiB;
static_assert(WS_STOK + (size_t)86016 * 4 <= 16 * MiB, "misc region 2");
constexpr size_t WS_WSM = 16 * MiB;
constexpr size_t WSM_LAYER = 15 * MiB, WSM_WINA = 0, WSM_WINU = 7 * MiB, WSM_WAP = 10 * MiB, WSM_WHP = 12 * MiB, WSM_WOUT = 13 * MiB;
constexpr size_t WS_BTR = WS_WSM + 2 * WSM_LAYER;
constexpr size_t WS_X = 48 * MiB;
constexpr size_t WS_KSPEC = 184 * MiB;
constexpr size_t WS_W13 = 248 * MiB;
constexpr size_t WS_W2T = 376 * MiB;
constexpr size_t WS_OV = 440 * MiB;
constexpr size_t WS_HX = WS_OV, WS_MG = WS_OV;
constexpr size_t WS_Q = WS_OV + 68 * MiB;
constexpr size_t WS_KB = 150 * MiB, WS_VB = 167 * MiB;
constexpr size_t WS_OY = WS_OV + 136 * MiB;
constexpr size_t WS_YHT = 116 * MiB;
constexpr size_t WS_UT = WS_OV + 238 * MiB;
constexpr size_t WS_G = WS_OV + 340 * MiB;
constexpr size_t WS_Y = WS_OV + 68 * MiB;
constexpr size_t WS_HXS = WS_OV + 236 * MiB;
constexpr size_t WS_HMID = WS_OV + 389 * MiB;
constexpr size_t WS_LOG = WS_OV + 372 * MiB;
constexpr size_t WS_FT = WS_OV + 476 * MiB;
constexpr size_t WS_W3S = WS_FT + 64 * MiB;
constexpr size_t WS_H2S = WS_W3S + 2 * MiB;
constexpr size_t WS_END = WS_H2S + 4 * MiB;
static_assert((size_t)R_ALL * 1024 * 2 <= 68 * MiB && (size_t)NB * SKV * 256 * 2 <= 17 * MiB && (size_t)R_ALL * 1536 * 2 <= 102 * MiB && WS_X + (size_t)R_ALL * 1024 * 2 <= WS_YHT && WS_YHT + 34 * MiB <= WS_KB && WS_VB + 17 * MiB <= WS_KSPEC && (size_t)1536 * R_ALL * 2 <= 102 * MiB, "sizes");
static_assert(WS_HMID + (size_t)NSLOT_MAX * 512 * 2 <= WS_END && (size_t)NSLOT_MAX * 1024 * 2 <= 168 * MiB && (size_t)R_ALL * 2048 * 2 <= 136 * MiB && (size_t)R_ALL * 128 * 4 <= 17 * MiB && WS_OY + 102 * MiB <= WS_UT, "sizes2");
constexpr int CW_BAR = 4096;
constexpr int RING_BYTES = 139264, MISC_OFF = RING_BYTES + 320, LDS_BYTES = 147456;

#define GAS __attribute__((address_space(1)))
#define LAS __attribute__((address_space(3)))
typedef unsigned short bf16;
typedef unsigned v4u __attribute__((ext_vector_type(4)));
typedef unsigned v2u __attribute__((ext_vector_type(2)));
typedef float f32x4 __attribute__((ext_vector_type(4)));
typedef float f32x2 __attribute__((ext_vector_type(2)));
__device__ __forceinline__ unsigned f2bf(float f) { unsigned u = __builtin_bit_cast(unsigned, f); return (u + 0x7fffu + ((u >> 16) & 1u)) >> 16; }
__device__ __forceinline__ unsigned pk2(float lo, float hi) { return f2bf(lo) | (f2bf(hi) << 16); }
__device__ __forceinline__ float bf2f(unsigned b) { return __uint_as_float(b << 16); }
__device__ __forceinline__ float wave_sum(float v) {
#define WS_SWZ(o) v += __int_as_float(__builtin_amdgcn_ds_swizzle(__float_as_int(v), ((o) << 10) | 0x1f))
    WS_SWZ(1); WS_SWZ(2); WS_SWZ(4); WS_SWZ(8); WS_SWZ(16);
#undef WS_SWZ
    { auto rr = __builtin_amdgcn_permlane32_swap(__float_as_uint(v), __float_as_uint(v), false, false); v = __uint_as_float(rr[0]) + __uint_as_float(rr[1]); }
    return v;
}
#define LDS_WAIT() asm volatile("s_waitcnt lgkmcnt(0)" ::: "memory")
__device__ __forceinline__ void* opaque_uptr(const void* p) {
    unsigned lo = (unsigned)(uintptr_t)p, hi = (unsigned)((uintptr_t)p >> 32);
    asm volatile("" : "+v"(lo), "+v"(hi));
    lo = __builtin_amdgcn_readfirstlane(lo); hi = __builtin_amdgcn_readfirstlane(hi);
    return (void*)(((uintptr_t)hi << 32) | (uintptr_t)lo);
}
constexpr int PTAB_OFF = RING_BYTES + 1024;
struct InTab { LAS const unsigned long long* t;
    __device__ __forceinline__ const float* operator[](int i) const { const unsigned long long v = t[i];
        const unsigned lo = __builtin_amdgcn_readfirstlane((unsigned)v), hi = __builtin_amdgcn_readfirstlane((unsigned)(v >> 32)); return (const float*)(const GAS float*)(((uintptr_t)hi << 32) | (uintptr_t)lo); } };
__device__ __forceinline__ int opaque_u32(int x) { unsigned v = (unsigned)x; asm volatile("" : "+v"(v)); return (int)__builtin_amdgcn_readfirstlane(v); }
#define XB_TMO      128
#define XB_XCNT(j)  (256  + 64 * (j))
#define XB_XSUB(j)  (1280 + 64 * (j))
#define XB_XGEN(j)  (2304 + 64 * (j))
#define XB_TOP      3328
#define XB_TOPGEN   3392
#define XCD_BAR_WORDS 3456
#define XB_SPIN_CAP (1u << 18)

__device__ __forceinline__ unsigned xb_ld(unsigned* p)              { return __hip_atomic_load(p, __ATOMIC_RELAXED, __HIP_MEMORY_SCOPE_AGENT); }
__device__ __forceinline__ unsigned xb_add(unsigned* p, unsigned v) { return __hip_atomic_fetch_add(p, v, __ATOMIC_RELAXED, __HIP_MEMORY_SCOPE_AGENT); }
__device__ __forceinline__ unsigned xb_xcc_id() { return (unsigned)__builtin_amdgcn_s_getreg((3 << 11) | 20) & 0xFu; }
#define XB_SPIN(cond, bar) do { unsigned _sp = 0; while (cond) { __builtin_amdgcn_s_sleep(1); \
    if ((++_sp & 255u) == 0u) { if (xb_ld(&(bar)[XB_TMO])) break; if (_sp > XB_SPIN_CAP) { atomicAdd(&(bar)[XB_TMO], 1u); break; } } } } while (0)

struct XcdBarrier {
    int w;
    unsigned* bar; unsigned x;
    volatile LAS unsigned* st;
};

__device__ __forceinline__ int xb_lane() { int l; asm volatile("v_mbcnt_lo_u32_b32 %0, -1, 0\n\tv_mbcnt_hi_u32_b32 %0, -1, %0" : "=v"(l)); return l; }
__device__ __forceinline__ XcdBarrier xcd_barrier_post(unsigned* bar, volatile LAS unsigned* st, int wave) {
    XcdBarrier b; b.w = wave; b.bar = bar; b.x = xb_xcc_id(); b.st = st;
    if (wave == 0 && xb_lane() == 0) (void)xb_add(&bar[XB_XCNT(b.x)], 1u);
    return b;
}
__device__ __forceinline__ void xcd_barrier_complete(unsigned* bar, unsigned x, unsigned& nloc, unsigned& nx) {
    const unsigned G = gridDim.x * gridDim.y * gridDim.z;
    unsigned sum, cnt, mine, sp = 0u;
    for (;;) {
        sum = 0u; cnt = 0u; mine = 0u;
#pragma unroll
        for (unsigned j = 0; j < 16; ++j) { const unsigned c = xb_ld(&bar[XB_XCNT(j)]); sum += c; cnt += (c > 0u) ? 1u : 0u; mine = (j == x) ? c : mine; }
        if (sum == G) break;
        __builtin_amdgcn_s_sleep(1);
        if ((++sp & 255u) == 0u) { if (xb_ld(&bar[XB_TMO])) break; if (sp > XB_SPIN_CAP) { atomicAdd(&bar[XB_TMO], 1u); break; } }
    }
    nloc = mine > 0u ? mine : 1u; nx = cnt > 0u ? cnt : 1u;
}

__device__ __forceinline__ void xcd_barrier(const XcdBarrier& b) {
    asm volatile("s_waitcnt vmcnt(0)" ::: "memory");
    __syncthreads();
    if (b.w == 0 && xb_lane() == 0) {
        unsigned* bar = b.bar;
        __builtin_amdgcn_s_waitcnt(0);
        unsigned nloc = b.st[0], nx = b.st[1];
        if (nloc == 0u) { xcd_barrier_complete(bar, b.x, nloc, nx); b.st[0] = nloc; b.st[1] = nx; }
        const unsigned old = xb_add(&bar[XB_XSUB(b.x)], 1u);
        const unsigned gen = old / nloc;
        if (old + 1u == (gen + 1u) * nloc) {
            __builtin_amdgcn_fence(__ATOMIC_RELEASE, "agent");
            asm volatile("s_waitcnt vmcnt(0)" ::: "memory");
            const unsigned og = xb_add(&bar[XB_TOP], 1u);
            const unsigned tg = og / nx;
            if (og + 1u == (tg + 1u) * nx) xb_add(&bar[XB_TOPGEN], 1u);
            else XB_SPIN(xb_ld(&bar[XB_TOPGEN]) == tg, bar);
            __builtin_amdgcn_fence(__ATOMIC_ACQUIRE, "agent");
            xb_add(&bar[XB_XGEN(b.x)], 1u);
            asm volatile("s_waitcnt vmcnt(0)" ::: "memory");
        } else {
            XB_SPIN(xb_ld(&bar[XB_XGEN(b.x)]) == gen, bar);
            __builtin_amdgcn_fence(__ATOMIC_ACQUIRE, "agent");
            asm volatile("s_waitcnt vmcnt(0)" ::: "memory");
        }
    }
    __syncthreads();
}

#define HD __device__ __forceinline__
#define FLDS LAS
#define SINCOSPI(x, s, c) sincospif(x, s, c)
#define SHFL_XOR1(x) __int_as_float(__builtin_amdgcn_mov_dpp(__float_as_int(x), 0xB1, 0xf, 0xf, true))
__device__ __forceinline__ f32x2 opaque_f2(f32x2 a) { asm volatile("" : "+v"(a)); return a; }
#define OPAQUE(x) opaque_f2(x)
HD f32x2 cmul(f32x2 a, f32x2 b) { return (f32x2){a.x * b.x - a.y * b.y, a.x * b.y + a.y * b.x}; }
HD f32x2 cmulc(f32x2 a, f32x2 b) { return (f32x2){a.x * b.x + a.y * b.y, a.y * b.x - a.x * b.y}; }
template <int SG> HD f32x2 muli(f32x2 a) { return SG < 0 ? (f32x2){a.y, -a.x} : (f32x2){-a.y, a.x}; }
template <int SG> HD void dft4(f32x2& a0, f32x2& a1, f32x2& a2, f32x2& a3) {
    const f32x2 t0 = a0 + a2, t1 = a0 - a2, t2 = a1 + a3, t3 = muli<SG>(a1 - a3);
    a0 = t0 + t2; a2 = t0 - t2; a1 = t1 + t3; a3 = t1 - t3;
}
template <int SG, int P> HD f32x2 tw16() {
    constexpr float C[16] = {1.f, 0.92387953251128674f, 0.70710678118654752f, 0.38268343236508977f, 0.f, -0.38268343236508977f, -0.70710678118654752f, -0.92387953251128674f,
                             -1.f, -0.92387953251128674f, -0.70710678118654752f, -0.38268343236508977f, 0.f, 0.38268343236508977f, 0.70710678118654752f, 0.92387953251128674f};
    constexpr float S[16] = {0.f, 0.38268343236508977f, 0.70710678118654752f, 0.92387953251128674f, 1.f, 0.92387953251128674f, 0.70710678118654752f, 0.38268343236508977f,
                             0.f, -0.38268343236508977f, -0.70710678118654752f, -0.92387953251128674f, -1.f, -0.92387953251128674f, -0.70710678118654752f, -0.38268343236508977f};
    return (f32x2){C[P & 15], (float)SG * S[P & 15]};
}
template <int SG> HD void dft16(f32x2 (&v)[16]) {
    dft4<SG>(v[0], v[4], v[8], v[12]); dft4<SG>(v[1], v[5], v[9], v[13]); dft4<SG>(v[2], v[6], v[10], v[14]); dft4<SG>(v[3], v[7], v[11], v[15]);
    v[5] = cmul(v[5], tw16<SG, 1>()); v[6] = cmul(v[6], tw16<SG, 2>()); v[7] = cmul(v[7], tw16<SG, 3>());
    v[9] = cmul(v[9], tw16<SG, 2>()); v[10] = muli<SG>(v[10]); v[11] = cmul(v[11], tw16<SG, 6>());
    v[13] = cmul(v[13], tw16<SG, 3>()); v[14] = cmul(v[14], tw16<SG, 6>()); v[15] = cmul(v[15], tw16<SG, 9>());
    dft4<SG>(v[0], v[1], v[2], v[3]); dft4<SG>(v[4], v[5], v[6], v[7]); dft4<SG>(v[8], v[9], v[10], v[11]); dft4<SG>(v[12], v[13], v[14], v[15]);
    f32x2 t;
#define SW(a, b) t = v[a]; v[a] = v[b]; v[b] = t
    SW(1, 4); SW(2, 8); SW(3, 12); SW(6, 9); SW(7, 13); SW(11, 14);
#undef SW
}
#ifndef TIE2
#define TIE2(a, b) asm volatile("" : "+v"(a), "+v"(b))
#endif
struct FftTw { f32x2 wA, wC, wI2b, wI2s, wI1b, wI1s; };
HD f32x2 cispi(float x) { float s, c; SINCOSPI(x, &s, &c); return (f32x2){c, s}; }
HD FftTw fft_tw_init(int tid) {
    FftTw w;
    const int m2 = tid & 31, k1 = tid >> 5, j1 = (tid >> 1) & 15, b = tid & 1;
    w.wA = cispi(-2.f * (float)tid / 8192.f);
    w.wC = cispi(-2.f * (float)m2 / 512.f);
    w.wI2b = cispi(-2.f * (float)((m2 * k1) & 8191) / 8192.f);
    w.wI2s = cispi(-2.f * (float)k1 / 256.f);
    w.wI1b = cispi(-2.f * (float)((b * j1) & 31) / 32.f);
    w.wI1s = cispi(-2.f * (float)j1 / 512.f);
    return w;
}
#define FFT_LDS_ELEMS (256 * 33)
template <int NEXT = 0> HD void fft_fA(int tid, f32x2 (&v)[16], const FftTw& w, FLDS f32x2* L) {
    dft16<-1>(v);
    const f32x2 wA0 = OPAQUE(w.wA); const f32x2 wA = NEXT ? cmul(wA0, (f32x2){0.9999997058628822f, -0.0007669903187427045f}) : wA0; f32x2 p = wA;
    const int q = tid >> 5, col = tid & 31;
    L[(0 * 16 + q) * 33 + col] = v[0];
#pragma unroll
    for (int k1 = 1; k1 < 16; ++k1) { TIE2(p, v[k1]); L[(k1 * 16 + q) * 33 + col] = cmul(v[k1], p); p = cmul(p, wA); }
}
HD void fft_fC1(int tid, const FftTw& w, FLDS f32x2* L) {
    const int k1 = tid >> 5, m2 = tid & 31;
    f32x2 v[16];
#pragma unroll
    for (int m1 = 0; m1 < 16; ++m1) v[m1] = L[(k1 * 16 + m1) * 33 + m2];
    dft16<-1>(v);
    const f32x2 wC = OPAQUE(w.wC); f32x2 p = wC;
    L[(k1 * 16 + 0) * 33 + m2] = v[0];
#pragma unroll
    for (int j1 = 1; j1 < 16; ++j1) { TIE2(p, v[j1]); L[(k1 * 16 + j1) * 33 + m2] = cmul(v[j1], p); p = cmul(p, wC); }
}
HD void fft_fC3(int tid, f32x2 (&v)[16], FLDS f32x2* L) {
    const int row = tid >> 1, b = tid & 1; const float sgn = b ? -1.f : 1.f;
#pragma unroll
    for (int m = 0; m < 16; ++m) {
        const f32x2 lo = L[row * 33 + m], hi = L[row * 33 + m + 16];
        v[m] = lo + sgn * hi;
    }
    if (b) {
#define TW32(M) v[M] = cmul(v[M], (f32x2){C32[M], -S32[M]})
        constexpr float C32[16] = {1.f, 0.98078528040323043f, 0.92387953251128674f, 0.83146961230254524f, 0.70710678118654752f, 0.55557023301960218f, 0.38268343236508977f, 0.19509032201612825f,
                                   0.f, -0.19509032201612825f, -0.38268343236508977f, -0.55557023301960218f, -0.70710678118654752f, -0.83146961230254524f, -0.92387953251128674f, -0.98078528040323043f};
        constexpr float S32[16] = {0.f, 0.19509032201612825f, 0.38268343236508977f, 0.55557023301960218f, 0.70710678118654752f, 0.83146961230254524f, 0.92387953251128674f, 0.98078528040323043f,
                                   1.f, 0.98078528040323043f, 0.92387953251128674f, 0.83146961230254524f, 0.70710678118654752f, 0.55557023301960218f, 0.38268343236508977f, 0.19509032201612825f};
        TW32(1); TW32(2); TW32(3); TW32(4); TW32(5); TW32(6); TW32(7); TW32(8); TW32(9); TW32(10); TW32(11); TW32(12); TW32(13); TW32(14); TW32(15);
#undef TW32
    }
    dft16<-1>(v);
}
HD void fft_iI1(int tid, f32x2 (&v)[16], const FftTw& w, FLDS f32x2* L) {
    const int row = tid >> 1, b = tid & 1; const float sgn = b ? -1.f : 1.f;
    dft16<1>(v);
    if (b) {
        constexpr float C32[16] = {1.f, 0.98078528040323043f, 0.92387953251128674f, 0.83146961230254524f, 0.70710678118654752f, 0.55557023301960218f, 0.38268343236508977f, 0.19509032201612825f,
                                   0.f, -0.19509032201612825f, -0.38268343236508977f, -0.55557023301960218f, -0.70710678118654752f, -0.83146961230254524f, -0.92387953251128674f, -0.98078528040323043f};
        constexpr float S32[16] = {0.f, 0.19509032201612825f, 0.38268343236508977f, 0.55557023301960218f, 0.70710678118654752f, 0.83146961230254524f, 0.92387953251128674f, 0.98078528040323043f,
                                   1.f, 0.98078528040323043f, 0.92387953251128674f, 0.83146961230254524f, 0.70710678118654752f, 0.55557023301960218f, 0.38268343236508977f, 0.19509032201612825f};
#define TW32(M) v[M] = cmul(v[M], (f32x2){C32[M], S32[M]})
        TW32(1); TW32(2); TW32(3); TW32(4); TW32(5); TW32(6); TW32(7); TW32(8); TW32(9); TW32(10); TW32(11); TW32(12); TW32(13); TW32(14); TW32(15);
#undef TW32
    }
    const f32x2 wb_ = OPAQUE(w.wI1b), ws_ = OPAQUE(w.wI1s);
    f32x2 p = (f32x2){wb_.x, -wb_.y};
    const f32x2 st = (f32x2){ws_.x, -ws_.y};
#pragma unroll
    for (int m = 0; m < 16; ++m) {
        f32x2 o; o.x = SHFL_XOR1(v[m].x); o.y = SHFL_XOR1(v[m].y);
        f32x2 r = o + sgn * v[m];
        TIE2(p, r); L[row * 33 + m + 16 * b] = cmul(r, p); p = cmul(p, st);
    }
}
template <bool HI = false> HD void fft_iI2(int tid, const FftTw& w, FLDS f32x2* L) {
    const int k1 = tid >> 5, m2 = tid & 31;
    f32x2 v[16];
#pragma unroll
    for (int j1 = 0; j1 < 16; ++j1) v[j1] = L[(k1 * 16 + j1) * 33 + m2];
    dft16<1>(v);
    const f32x2 wb_ = OPAQUE(w.wI2b), ws0_ = OPAQUE(w.wI2s); const f32x2 ws_ = HI ? cmul(ws0_, (f32x2){0.98078528040323043f, -0.19509032201612825f}) : ws0_;
    f32x2 p = (f32x2){wb_.x, -wb_.y};
    const f32x2 st = (f32x2){ws_.x, -ws_.y};
#pragma unroll
    for (int m1 = 0; m1 < 16; ++m1) { TIE2(p, v[m1]); L[(k1 * 16 + m1) * 33 + m2] = cmul(v[m1], p); p = cmul(p, st); }
}
HD void fft_iI3(int tid, f32x2 (&v)[16], FLDS f32x2* L) {
    const int q = tid >> 5, col = tid & 31;
#pragma unroll
    for (int k1 = 0; k1 < 16; ++k1) v[k1] = L[(k1 * 16 + q) * 33 + col];
    dft16<1>(v);
}
template <bool TRAIL> HD void fft_fwd(int tid, f32x2 (&v)[16], const FftTw& tw, LAS f32x2* Lb) {
    fft_fA(tid, v, tw, Lb); __syncthreads(); fft_fC1(tid, tw, Lb); __syncthreads(); fft_fC3(tid, v, Lb); if (TRAIL) __syncthreads();
}
template <bool TRAIL> HD void fft_inv(int tid, f32x2 (&v)[16], const FftTw& tw, LAS f32x2* Lb) {
    fft_iI1(tid, v, tw, Lb); __syncthreads(); fft_iI2(tid, tw, Lb); __syncthreads(); fft_iI3(tid, v, Lb); if (TRAIL) __syncthreads();
}

__device__ __forceinline__ void tr_item(const float* W, int ldn, int k0, int n0, bf16* WT, int Kd, int drow0, LAS float* scr, int lane) {
    const float* src = W + (size_t)(k0 + (lane >> 5)) * ldn + n0 + (lane & 31) * 2;
    f32x2 r[32];
#pragma unroll
    for (int i = 0; i < 32; ++i) r[i] = *(const f32x2*)(src + (size_t)(2 * i) * ldn);
    LAS float* d = scr + (lane >> 5) * 65 + (lane & 31) * 2;
#pragma unroll
    for (int i = 0; i < 32; ++i) { d[(2 * i) * 65] = r[i].x; d[(2 * i) * 65 + 1] = r[i].y; }
    LDS_WAIT(); asm volatile("" ::: "memory");
    const int c = lane & 7;
#pragma unroll
    for (int j = 0; j < 8; ++j) { const int n = (lane >> 3) + 8 * j; const LAS float* s = scr + (8 * c) * 65 + n;
        v4u o; o.x = pk2(s[0 * 65], s[1 * 65]); o.y = pk2(s[2 * 65], s[3 * 65]); o.z = pk2(s[4 * 65], s[5 * 65]); o.w = pk2(s[6 * 65], s[7 * 65]);
        *(GAS v4u*)(WT + (size_t)(drow0 + n) * Kd + k0 + 8 * c) = o; }
    LDS_WAIT(); asm volatile("" ::: "memory");
}
struct Ptrs {
    const float* in[N_IN]; float* out; unsigned char* ws;
};
__device__ __forceinline__ bf16* wsm(unsigned char* ws, int L, size_t off) { return (bf16*)(ws + WS_WSM + (size_t)L * WSM_LAYER + off); }
constexpr int SMALL_ITEMS = 1280 + 256 + 128 + 256, EXPERT_ITEMS = 64 * 384;
__device__ __forceinline__ void conv_small_item(int it, int L, const InTab in, unsigned char* ws, LAS float* scr, int lane) {
    if (it < 1280) { const int kb = it / 80, n0 = 64 * (it % 80); const float* W = in[I_WIN] + (size_t)L * 1024 * INW;
        if (n0 < 1536) tr_item(W, INW, 64 * kb, n0, wsm(ws, L, WSM_WINA), 1024, n0, scr, lane);
        else if (n0 < 3072) tr_item(W, INW, 64 * kb, n0, wsm(ws, L, WSM_WINU), 1024, n0 - 1536, scr, lane);
        else tr_item(W, INW, 64 * kb, n0, wsm(ws, L, WSM_WINA), 1024, n0 - 1536, scr, lane);
        return; }
    it -= 1280;
    if (it < 256) { tr_item(in[I_WAP] + (size_t)L * 1024 * 1024, 1024, 64 * (it / 16), 64 * (it % 16), wsm(ws, L, WSM_WAP), 1536, 64 * (it % 16), scr, lane); return; }
    it -= 256;
    if (it < 128) { tr_item(in[I_WHP] + (size_t)L * 512 * 1024, 1024, 64 * (it / 16), 64 * (it % 16), wsm(ws, L, WSM_WAP) + 1024, 1536, 64 * (it % 16), scr, lane); return; }
    it -= 128;
    tr_item(in[I_WOUT] + (size_t)L * 1024 * 1024, 1024, 64 * (it / 16), 64 * (it % 16), wsm(ws, L, WSM_WOUT), 1024, 64 * (it % 16), scr, lane);
}
__device__ __forceinline__ void conv_expert_item(int it, int L, const InTab in, unsigned char* ws, LAS float* scr, int lane) {
    const int e = it / 384; int r = it % 384; bf16* W13 = (bf16*)(ws + WS_W13); bf16* W2T = (bf16*)(ws + WS_W2T);
    if (r < 256) { const bool third = r >= 128; r &= 127; const int kb = r / 8, n0 = 64 * (r % 8);
        const float* W = in[third ? I_EW3 : I_EW1] + (size_t)(L * NE + e) * 1024 * 512;
        tr_item(W, 512, 64 * kb, n0, W13, 1024, e * 1024 + (n0 >> 7) * 256 + (third ? 128 : 0) + (n0 & 127), scr, lane); return; }
    r -= 256;
    tr_item(in[I_EW2] + (size_t)(L * NE + e) * 512 * 1024, 1024, 64 * (r / 16), 64 * (r % 16), W2T, 512, e * 1024 + 64 * (r % 16), scr, lane);
}
__device__ __forceinline__ void mods_partial_unit(int u, const InTab in, unsigned char* ws, int lane) {
    const int L = u / 384, r0 = u % 384, cg = r0 / 16, ks = r0 % 16, col = cg * 256 + lane * 4;
    f32x4 acc[9];
#pragma unroll
    for (int r = 0; r < 9; ++r) acc[r] = (f32x4){0.f, 0.f, 0.f, 0.f};
    const float* W = in[I_WADA] + (size_t)L * 1024 * 6144 + col; const float* cv = in[I_C]; const float* cc = in[I_CCTX];
#pragma unroll 4
    for (int kk = 0; kk < 64; ++kk) { const int k = ks * 64 + kk; const f32x4 w = *(const f32x4*)(W + (size_t)k * 6144);
#pragma unroll
        for (int r = 0; r < 9; ++r) { const float x = (r < 8) ? cv[r * 1024 + k] : cc[k]; const float s = x / (1.f + expf(-x)); acc[r] += s * w; } }
    float* P = (float*)(ws + WS_MODP) + ((size_t)(ks * 2 + L) * 9) * 6144 + col;
#pragma unroll
    for (int r = 0; r < 9; ++r) *(f32x4*)(P + (size_t)r * 6144) = acc[r];
}
__device__ __forceinline__ void h2_rows(int L, int p0, int pstride, const InTab in, unsigned char* ws, int lane) {
    const float* w1 = in[I_PW1] + (size_t)L * 33 * 64; const float* w2 = in[I_PW2] + (size_t)L * 64 * 64;
    float w1c[33], w2c[64];
#pragma unroll
    for (int i = 0; i < 33; ++i) w1c[i] = w1[i * 64 + lane];
#pragma unroll
    for (int i = 0; i < 64; ++i) w2c[i] = w2[i * 64 + lane];
    const float b1 = in[I_PB1][L * 64 + lane], f1 = in[I_PF1][L * 64 + lane], b2 = in[I_PB2][L * 64 + lane], f2 = in[I_PF2][L * 64 + lane];
    float* H2 = (float*)(ws + WS_H2) + (size_t)L * 4352 * 64;
    for (int p = p0; p < 4352; p += pstride) {
        const int Ls = p < 4096 ? 4096 : 256, pos = p < 4096 ? p : p - 4096;
        float zl = 0.f;
        if (lane == 0) zl = (float)((double)pos / (double)(Ls - 1));
        else if (lane < 33) { const int bi = (lane - 1) & 15; const double band = 1e-4 + (double)bi * ((15.0 - 1e-4) / 15.0);
            const double f = 2.0 * 3.14159265358979323846 * (double)pos * band / (double)Ls;
            zl = lane < 17 ? (float)cos(f) : (float)(-sin(f)); }
        float a = b1;
#pragma unroll
        for (int i = 0; i < 33; ++i) a += __builtin_bit_cast(float, __builtin_amdgcn_readlane(__builtin_bit_cast(int, zl), i)) * w1c[i];
        const float h1 = sinf(f1 * a);
        float a2 = b2;
#pragma unroll
        for (int i = 0; i < 64; ++i) a2 += __builtin_bit_cast(float, __builtin_amdgcn_readlane(__builtin_bit_cast(int, h1), i)) * w2c[i];
        const float h2v = sinf(f2 * a2);
        H2[(size_t)p * 64 + lane] = h2v;
        if (p < 4096) { bf16* hs = (bf16*)(ws + WS_H2S) + ((size_t)L * 4096 + p) * 256; const unsigned hi = f2bf(h2v), lo = f2bf(h2v - bf2f(hi));
            hs[lane] = (bf16)hi; hs[64 + lane] = (bf16)lo; hs[128 + lane] = (bf16)hi; hs[192 + lane] = (bf16)0; }
    }
}
struct RowVec { f32x4 v[4]; };
__device__ __forceinline__ float row_sumsq(const RowVec& x) { float s = 0.f;
#pragma unroll
    for (int j = 0; j < 4; ++j) s += (x.v[j].x * x.v[j].x + x.v[j].y * x.v[j].y) + (x.v[j].z * x.v[j].z + x.v[j].w * x.v[j].w);
    return wave_sum(s); }
__device__ __forceinline__ void row_load_bf(RowVec& x, const bf16* p, int lane) {
#pragma unroll
    for (int j = 0; j < 4; ++j) { const v2u w = *(const v2u*)(p + 4 * lane + 256 * j); x.v[j] = (f32x4){bf2f(w.x & 0xffffu), bf2f(w.x >> 16), bf2f(w.y & 0xffffu), bf2f(w.y >> 16)}; } }
__device__ __forceinline__ void row_store_bf(const RowVec& x, bf16* p, int lane) {
#pragma unroll
    for (int j = 0; j < 4; ++j) { v2u o; o.x = pk2(x.v[j].x, x.v[j].y); o.y = pk2(x.v[j].z, x.v[j].w); *(v2u*)(p + 4 * lane + 256 * j) = o; } }
__device__ __forceinline__ void row_load(RowVec& x, const float* p, int lane) {
#pragma unroll
    for (int j = 0; j < 4; ++j) x.v[j] = *(const f32x4*)(p + 4 * lane + 256 * j); }
__device__ __forceinline__ void row_combine(RowVec& x, int row, const float* g2row, unsigned char* ws, int lane) {
    const int2 s = ((const int2*)(ws + WS_TOKS))[row]; const float2 g = ((const float2*)(ws + WS_TOKG))[row];
    const bf16* Y = (const bf16*)(ws + WS_Y);
#pragma unroll
    for (int j = 0; j < 4; ++j) { const int col = 4 * lane + 256 * j;
        const v2u a = *(const v2u*)(Y + (size_t)s.x * 1024 + col), b = *(const v2u*)(Y + (size_t)s.y * 1024 + col); const f32x4 gg = *(const f32x4*)(g2row + col);
        f32x4 f;
        f.x = g.x * bf2f(a.x & 0xffffu) + g.y * bf2f(b.x & 0xffffu); f.y = g.x * bf2f(a.x >> 16) + g.y * bf2f(b.x >> 16);
        f.z = g.x * bf2f(a.y & 0xffffu) + g.y * bf2f(b.y & 0xffffu); f.w = g.x * bf2f(a.y >> 16) + g.y * bf2f(b.y >> 16);
        x.v[j] += gg * f; }
}
__device__ __forceinline__ void norm1_load(RowVec& x, int L, int row, const InTab in, unsigned char* ws, int lane) {
    const float* mods = (const float*)(ws + WS_MODS); const bf16* X = (const bf16*)(ws + WS_X);
    if (L == 0) row_load(x, row < T_LAT ? in[I_X] + (size_t)row * 1024 : in[I_CTX] + (size_t)(row - T_LAT) * 1024, lane);
    else { row_load_bf(x, X + (size_t)row * 1024, lane); row_combine(x, row, mods + (size_t)(0 * 9 + (row < T_LAT ? row / SEQ : 8)) * 6144 + 5 * 1024, ws, lane); }
}
__device__ __forceinline__ void norm1_finish(const RowVec& x, int L, int row, const float* nw, unsigned char* ws, int lane) {
    const float* mods = (const float*)(ws + WS_MODS); bf16* X = (bf16*)(ws + WS_X); bf16* HX = (bf16*)(ws + WS_HX);
    const int mr = row < T_LAT ? row / SEQ : 8;
    if (L != 0) row_store_bf(x, X + (size_t)row * 1024, lane);
    const float rstd = rsqrtf(row_sumsq(x) * (1.f / 1024.f) + EPS);
    const float* mrow = mods + (size_t)(L * 9 + mr) * 6144;
#pragma unroll
    for (int j = 0; j < 4; ++j) { const int col = 4 * lane + 256 * j; const f32x4 w = *(const f32x4*)(nw + col), sh = *(const f32x4*)(mrow + col), sc = *(const f32x4*)(mrow + 1024 + col);
        const f32x4 h = (x.v[j] * rstd * w) * (1.f + sc) + sh;
        v2u o; o.x = pk2(h.x, h.y); o.y = pk2(h.z, h.w); *(v2u*)(HX + (size_t)row * 1024 + col) = o; }
}
__device__ __forceinline__ void phase_norm1(int L, const InTab in, unsigned char* ws, int gw, int NGW, int lane) {
    const float* nw = in[I_N1W] + L * 1024;
    for (int r0 = gw; r0 < R_ALL; r0 += 2 * NGW) {
        const int r1 = r0 + NGW; const bool two = r1 < R_ALL; const int r1c = two ? r1 : r0;
        RowVec xa, xb; norm1_load(xa, L, r0, in, ws, lane); norm1_load(xb, L, r1c, in, ws, lane);
        norm1_finish(xa, L, r0, nw, ws, lane); if (two) norm1_finish(xb, L, r1c, nw, ws, lane);
    }
}
__device__ __forceinline__ void norm2_finish(const RowVec& x, int L, int row, const float* nw, unsigned char* ws, int lane) {
    const float* mods = (const float*)(ws + WS_MODS); bf16* HXS = (bf16*)(ws + WS_HXS);
    const int mr = row < T_LAT ? row / SEQ : 8;
    const float rstd = rsqrtf(row_sumsq(x) * (1.f / 1024.f) + EPS);
    const float* mrow = mods + (size_t)(L * 9 + mr) * 6144;
#pragma unroll
    for (int j = 0; j < 4; ++j) { const int col = 4 * lane + 256 * j; const f32x4 w = *(const f32x4*)(nw + col), sh = *(const f32x4*)(mrow + 3 * 1024 + col), sc = *(const f32x4*)(mrow + 4 * 1024 + col);
        const f32x4 h = (x.v[j] * rstd * w) * (1.f + sc) + sh;
        v2u o; o.x = pk2(h.x, h.y); o.y = pk2(h.z, h.w); *(v2u*)(HXS + (size_t)row * 1024 + col) = o; }
}
__device__ __forceinline__ void phase_norm2(int L, int nrows, const InTab in, unsigned char* ws, int gw, int NGW, int lane) {
    const float* nw = in[I_N2W] + L * 1024; const bf16* X = (const bf16*)(ws + WS_X);
    for (int r0 = gw; r0 < nrows; r0 += 2 * NGW) {
        const int r1 = r0 + NGW; const bool two = r1 < nrows; const int r1c = two ? r1 : r0;
        RowVec xa, xb; row_load_bf(xa, X + (size_t)r0 * 1024, lane); row_load_bf(xb, X + (size_t)r1c * 1024, lane);
        norm2_finish(xa, L, r0, nw, ws, lane); if (two) norm2_finish(xb, L, r1c, nw, ws, lane);
    }
}
__device__ __forceinline__ void final_finish(const RowVec& x, int row, const float* nw, float* out, int lane) {
    const float rstd = rsqrtf(row_sumsq(x) * (1.f / 1024.f) + EPS);
#pragma unroll
    for (int j = 0; j < 4; ++j) { const int col = 4 * lane + 256 * j; *(f32x4*)(out + (size_t)row * 1024 + col) = x.v[j] * rstd * *(const f32x4*)(nw + col); }
}
__device__ __forceinline__ void phase_final(const InTab in, float* out, unsigned char* ws, int gw, int NGW, int lane) {
    const float* mods = (const float*)(ws + WS_MODS); const float* nw = in[I_FNW]; const bf16* X = (const bf16*)(ws + WS_X);
    for (int r0 = gw; r0 < T_LAT; r0 += 2 * NGW) {
        const int r1 = r0 + NGW;
        RowVec xa, xb; row_load_bf(xa, X + (size_t)r0 * 1024, lane); row_load_bf(xb, X + (size_t)r1 * 1024, lane);
        row_combine(xa, r0, mods + (size_t)(1 * 9 + r0 / SEQ) * 6144 + 5 * 1024, ws, lane); row_combine(xb, r1, mods + (size_t)(1 * 9 + r1 / SEQ) * 6144 + 5 * 1024, ws, lane);
        final_finish(xa, r0, nw, out, lane); final_finish(xb, r1, nw, out, lane);
    }
}
__device__ __forceinline__ void phase_kpost(int L, const InTab in, unsigned char* ws, int gw, int NGW, int lane) {
    bf16* KB = (bf16*)(ws + WS_KB); const float* knw = in[I_KNW] + L * 128; const float2* rope = (const float2*)(ws + WS_ROPE);
    for (int it = gw * 64 + lane; it < NB * SKV * NKV; it += NGW * 64) {
        const int kvrow = it >> 1, hd = it & 1, t = kvrow % SKV;
        v4u* p = (v4u*)(KB + (size_t)kvrow * 256 + hd * 128);
        v4u raw[16]; float ss = 0.f;
#pragma unroll
        for (int q = 0; q < 16; ++q) { raw[q] = p[q];
#pragma unroll
            for (int i = 0; i < 4; ++i) { const float a = bf2f(raw[q][i] & 0xffffu), b = bf2f(raw[q][i] >> 16); ss += a * a + b * b; } }
        const float rstd = rsqrtf(ss * (1.f / 128.f) + EPS);
        const bool lat = t < SEQ; const float2* tr = rope + (t >> 6) * 32; const float2* tc = rope + (t & 63) * 32;
#pragma unroll
        for (int q = 0; q < 8; ++q) {
            v4u wa, wb;
#pragma unroll
            for (int i = 0; i < 4; ++i) { const int j = 8 * q + 2 * i;
                float a0 = bf2f(raw[q][i] & 0xffffu) * rstd * knw[j], a1 = bf2f(raw[q][i] >> 16) * rstd * knw[j + 1];
                float b0 = bf2f(raw[q + 8][i] & 0xffffu) * rstd * knw[j + 64], b1 = bf2f(raw[q + 8][i] >> 16) * rstd * knw[j + 65];
                if (lat) { const float2 c0 = j < 32 ? tr[j] : tc[j - 32], c1 = j < 32 ? tr[j + 1] : tc[j - 31];
                    const float x0 = a0 * c0.x - b0 * c0.y, y0 = a0 * c0.y + b0 * c0.x, x1 = a1 * c1.x - b1 * c1.y, y1 = a1 * c1.y + b1 * c1.x; a0 = x0; b0 = y0; a1 = x1; b1 = y1; }
                wa[i] = pk2(a0, a1); wb[i] = pk2(b0, b1); }
            p[q] = wa; p[q + 8] = wb; }
    }
}
__device__ __forceinline__ void phase_transpose(unsigned char* ws, LAS unsigned char* lds, int wave, int gw, int NGW, int lane) {
    const bf16* YHT = (const bf16*)(ws + WS_YHT); bf16* YH = (bf16*)(ws + WS_OY) + 1024;
    LAS bf16* tile = (LAS bf16*)(lds + wave * 9216);
    for (int it = gw; it < 8 * (R_ALL / 64); it += NGW) {
        const int cb = it & 7, rb = it >> 3;
#pragma unroll
        for (int i = 0; i < 8; ++i) { const int ch = i * 8 + (lane >> 3), tk = (lane & 7) * 8;
            const v4u w = *(const v4u*)(YHT + (size_t)(cb * 64 + ch) * R_ALL + rb * 64 + tk);
#pragma unroll
            for (int q = 0; q < 4; ++q) { tile[(tk + 2 * q) * 72 + ch] = (bf16)(w[q] & 0xffffu); tile[(tk + 2 * q + 1) * 72 + ch] = (bf16)(w[q] >> 16); } }
        LDS_WAIT(); asm volatile("" ::: "memory");
#pragma unroll
        for (int i = 0; i < 8; ++i) { const int tk = i * 8 + (lane >> 3), c8 = (lane & 7) * 8;
            const v4u w = *(const LAS v4u*)(tile + tk * 72 + c8);
            *(v4u*)(YH + (size_t)(rb * 64 + tk) * 1536 + cb * 64 + c8) = w; }
        LDS_WAIT(); asm volatile("" ::: "memory");
    }
}
__device__ __forceinline__ float hy_delta(int c) { return 3.070113457325394f + (float)c * 0.024032199274562772f; }
typedef _Float16 hy_h2 __attribute__((ext_vector_type(2)));
__device__ __forceinline__ unsigned hy_pkh(f32x2 x) { return __builtin_bit_cast(unsigned, (hy_h2){(_Float16)x.x, (_Float16)x.y}); }
__device__ __forceinline__ f32x2 hy_uph(unsigned w) { const hy_h2 h = __builtin_bit_cast(hy_h2, w); return (f32x2){(float)h.x, (float)h.y}; }
__device__ __forceinline__ void filter_fft_unit(int c, int L, const InTab in, unsigned char* ws, LAS unsigned char* lds, int tid, const FftTw& tw) {
    LAS f32x2* Lb = (LAS f32x2*)lds;
    const float* F = (const float*)(ws + WS_FT) + (size_t)L * 2048 * 4096;
    v2u* K = (v2u*)(ws + WS_KSPEC);
    __syncthreads();
#pragma unroll 1
    for (int o = 0; o < 2; ++o) {
        const float* hf = F + (size_t)(o * 1024 + c) * 4096; const float* hb = F + (size_t)(o * 1024 + 512 + c) * 4096;
        f32x2 v[16];
#pragma unroll
        for (int n1 = 0; n1 < 8; ++n1) v[n1] = (f32x2){hf[512 * n1 + tid], 0.f};
        v[8] = (f32x2){tid == 0 ? 0.f : hb[4096 - tid], 0.f};
#pragma unroll
        for (int n1 = 9; n1 < 16; ++n1) v[n1] = (f32x2){hb[512 * (16 - n1) - tid], 0.f};
        fft_fwd<true>(tid, v, tw, Lb);
#pragma unroll
        for (int a = 0; a < 8; ++a) { const f32x2 u0 = v[2 * a] * (1.f / 64.f), u1 = v[2 * a + 1] * (1.f / 64.f);
            K[((size_t)(c * 2 + o) * 8 + a) * 512 + tid] = (v2u){hy_pkh(u0), hy_pkh(u1)}; }
    }
}
__device__ __forceinline__ float sconv(const bf16* row, int t, int len, float w0, float w1, float w2, float b) {
    const float l = t > 0 ? bf2f(row[t - 1]) : 0.f, m = bf2f(row[t]), r = t < len - 1 ? bf2f(row[t + 1]) : 0.f;
    return l * w0 + m * w1 + r * w2 + b;
}
__device__ __forceinline__ float sconv3(const bf16* tp, int off, bool lv, bool rv, float w0, float w1, float w2, float b) {
    const unsigned l = tp[off - 1], m = tp[off], r = tp[off + 1];
    return (lv ? bf2f(l) : 0.f) * w0 + bf2f(m) * w1 + (rv ? bf2f(r) : 0.f) * w2 + b;
}
struct __attribute__((packed, aligned(4))) HyU3 { unsigned a, b, c; };
__device__ __forceinline__ f32x2 sconv3x2u(const HyU3 u, bool lv, bool rv, float w0, float w1, float w2, float b) {
    const float em = __uint_as_float(u.a & 0xffff0000u), e0 = __uint_as_float(u.b << 16), e1 = __uint_as_float(u.b & 0xffff0000u), e2 = __uint_as_float(u.c << 16);
    return (f32x2){(lv ? em : 0.f) * w0 + e0 * w1 + e1 * w2 + b, e0 * w0 + e1 * w1 + (rv ? e2 : 0.f) * w2 + b};
}
__device__ __forceinline__ f32x2 sconv3x2(const bf16* tp, int off, bool lv, bool rv, float w0, float w1, float w2, float b) { return sconv3x2u(*(const HyU3*)(tp + off - 2), lv, rv, w0, w1, w2, b); }
__device__ __forceinline__ void gbar(volatile LAS unsigned* cnt, unsigned& epoch, int lane) {
    asm volatile("s_waitcnt lgkmcnt(0)" ::: "memory");
    epoch += 4u;
    if (lane == 0) (void)__hip_atomic_fetch_add((LAS unsigned*)cnt, 1u, __ATOMIC_RELAXED, __HIP_MEMORY_SCOPE_WORKGROUP);
    while ((unsigned)__builtin_amdgcn_readfirstlane(*cnt) < epoch) __builtin_amdgcn_s_sleep(1);
    asm volatile("" ::: "memory");
}
__device__ __forceinline__ void hyena_unit(int c, int L, const InTab in, unsigned char* ws, LAS unsigned char* lds, int tid, volatile LAS unsigned* gcnt, unsigned& epoch) {
    const int g = tid >> 8, t0 = tid & 255, t1 = t0 + 256, lane = tid & 63;
    LAS f32x2* Lb = (LAS f32x2*)(lds + g * 67584); volatile LAS unsigned* cnt = gcnt + 16 * g;
    FftTw twA = fft_tw_init(t0); twA.wA = cispi(-2.f * (float)(2 * t0) / 8192.f);
    FftTw twB = twA; { const int m2 = t1 & 31, k1 = t1 >> 5; twB.wI2b = cispi(-2.f * (float)((m2 * k1) & 8191) / 8192.f); }
    const float* cw = in[I_HCW] + (size_t)L * 3 * 1536; const float* cb = in[I_HCB] + (size_t)L * 1536; const float* sk = in[I_SKIP] + (size_t)L * 2 * 512;
    const float a0 = cw[c], a1 = cw[1536 + c], a2 = cw[3072 + c], ab = cb[c];
    const float b0 = cw[512 + c], b1 = cw[1536 + 512 + c], b2 = cw[3072 + 512 + c], bb = cb[512 + c];
    const float v0 = cw[1024 + c], v1 = cw[1536 + 1024 + c], v2 = cw[3072 + 1024 + c], vb = cb[1024 + c];
    const float skip0 = sk[c], skip1 = sk[512 + c];
    const bf16* UT = (const bf16*)(ws + WS_UT); bf16* YHT = (bf16*)(ws + WS_YHT);
    const v2u* K1 = (const v2u*)(ws + WS_KSPEC) + (size_t)(c * 2 + 0) * 8 * 512; const v2u* K2 = K1 + 8 * 512;
#define KP_PUT(arr, n1, val) arr[n1] = __builtin_bit_cast(unsigned, __builtin_amdgcn_cvt_pkrtz((val).x, (val).y))
#define KP_GET(arr, n1) ({ const __fp16 __attribute__((ext_vector_type(2))) h_ = __builtin_bit_cast(__fp16 __attribute__((ext_vector_type(2))), arr[n1]); (f32x2){(float)h_.x, (float)h_.y}; })
#pragma unroll 1
    for (int pp = 0; pp < 2; ++pp) {
        const int p = 2 * g + pp;
        const bf16* x1r = UT + (size_t)c * R_ALL + (size_t)(2 * p) * SEQ; const bf16* x2r = UT + (size_t)(512 + c) * R_ALL + (size_t)(2 * p) * SEQ; const bf16* vr = UT + (size_t)(1024 + c) * R_ALL + (size_t)(2 * p) * SEQ;
        bf16* yr = YHT + (size_t)c * R_ALL + (size_t)(2 * p) * SEQ;
        int tp = t0; asm volatile("" : "+v"(tp));
        f32x2 vA[16], vB[16]; unsigned kA[8], kB[8];
        { const bf16* vt = vr + 2 * tp;
#pragma unroll
          for (int n1 = 0; n1 < 8; ++n1) { const bool lv = !(n1 == 0 && t0 == 0), rv = !(n1 == 7 && t0 == 255);
            const f32x2 c0 = sconv3x2(vt, 512 * n1, lv, rv, v0, v1, v2, vb), c1 = sconv3x2(vt + SEQ, 512 * n1, lv, rv, v0, v1, v2, vb);
            vA[n1] = (f32x2){c0.x, c1.x}; vB[n1] = (f32x2){c0.y, c1.y}; KP_PUT(kA, n1, vA[n1]); KP_PUT(kB, n1, vB[n1]); } }
#pragma unroll
        for (int n1 = 8; n1 < 16; ++n1) { vA[n1] = (f32x2){0.f, 0.f}; vB[n1] = (f32x2){0.f, 0.f}; }
#define HY_CONV(K, ROWP) \
        fft_fA(2 * t0, vA, twA, Lb); fft_fA<1>(2 * t0 + 1, vB, twA, Lb); \
        v2u kq[16]; _Pragma("unroll") for (int a = 0; a < 8; ++a) { kq[2 * a] = K[a * 512 + tp]; kq[2 * a + 1] = K[a * 512 + 256 + tp]; } \
        gbar(cnt, epoch, lane); fft_fC1(t0, twA, Lb); fft_fC1(t1, twB, Lb); gbar(cnt, epoch, lane); fft_fC3(t0, vA, Lb); fft_fC3(t1, vB, Lb); \
        _Pragma("unroll") for (int a = 0; a < 8; ++a) { const v2u ka = kq[2 * a], kb = kq[2 * a + 1]; \
            vA[2 * a] = cmul(vA[2 * a], hy_uph(ka.x)); vA[2 * a + 1] = cmul(vA[2 * a + 1], hy_uph(ka.y)); vB[2 * a] = cmul(vB[2 * a], hy_uph(kb.x)); vB[2 * a + 1] = cmul(vB[2 * a + 1], hy_uph(kb.y)); } \
        fft_iI1(t0, vA, twA, Lb); fft_iI1(t1, vB, twB, Lb); \
        HyU3 u0[8], u1[8]; _Pragma("unroll") for (int n1 = 0; n1 < 8; ++n1) { u0[n1] = *(const HyU3*)((ROWP) + 512 * n1 - 2); u1[n1] = *(const HyU3*)((ROWP) + SEQ + 512 * n1 - 2); } \
        gbar(cnt, epoch, lane); fft_iI2(t0, twA, Lb); fft_iI2<true>(t1, twB, Lb); gbar(cnt, epoch, lane); fft_iI3(2 * t0, vA, Lb); fft_iI3(2 * t0 + 1, vB, Lb)
        { HY_CONV(K1, x1r + 2 * tp);
#pragma unroll
          for (int n1 = 0; n1 < 8; ++n1) { const bool lv = !(n1 == 0 && t0 == 0), rv = !(n1 == 7 && t0 == 255);
            const f32x2 c0 = sconv3x2u(u0[n1], lv, rv, a0, a1, a2, ab), c1 = sconv3x2u(u1[n1], lv, rv, a0, a1, a2, ab);
            const f32x2 xa = (f32x2){c0.x, c1.x}, xb = (f32x2){c0.y, c1.y};
            vA[n1] = xa * (vA[n1] * (1.f / 128.f) + skip0 * KP_GET(kA, n1)); vB[n1] = xb * (vB[n1] * (1.f / 128.f) + skip0 * KP_GET(kB, n1)); KP_PUT(kA, n1, vA[n1]); KP_PUT(kB, n1, vB[n1]); } }
#pragma unroll
        for (int n1 = 8; n1 < 16; ++n1) { vA[n1] = (f32x2){0.f, 0.f}; vB[n1] = (f32x2){0.f, 0.f}; }
        { HY_CONV(K2, x2r + 2 * tp); bf16* yt = yr + 2 * tp;
#pragma unroll
          for (int n1 = 0; n1 < 8; ++n1) { const bool lv = !(n1 == 0 && t0 == 0), rv = !(n1 == 7 && t0 == 255);
            const f32x2 c0 = sconv3x2u(u0[n1], lv, rv, b0, b1, b2, bb), c1 = sconv3x2u(u1[n1], lv, rv, b0, b1, b2, bb);
            const f32x2 xa = (f32x2){c0.x, c1.x}, xb = (f32x2){c0.y, c1.y};
            const f32x2 ya = xa * (vA[n1] * (1.f / 128.f) + skip1 * KP_GET(kA, n1)), yb = xb * (vB[n1] * (1.f / 128.f) + skip1 * KP_GET(kB, n1));
            *(unsigned*)(yt + 512 * n1) = pk2(ya.x, yb.x); *(unsigned*)(yt + SEQ + 512 * n1) = pk2(ya.y, yb.y); } }
    }
#undef HY_CONV
#undef KP_PUT
#undef KP_GET
}
__device__ __forceinline__ void hyena_ctx_conv(const LAS float* G, const LAS float* src  , LAS float* P  , int tid) {
    const int h = tid >> 8, t = tid & 255;
    f32x4 a0 = (f32x4){0.f, 0.f, 0.f, 0.f}, a1 = a0;
    const LAS float* g = G + 255 - t + 128 * h; const LAS f32x4* sv = (const LAS f32x4*)(src + 128 * h * 8);
#pragma unroll 8
    for (int s = 0; s < 128; ++s) { const float k = g[s]; a0 += k * sv[2 * s]; a1 += k * sv[2 * s + 1]; }
    LAS f32x4* o = (LAS f32x4*)(P + (h * 256 + t) * 8); o[0] = a0; o[1] = a1;
}
__device__ __forceinline__ void hyena_ctx_unit(int c, int L, const InTab in, unsigned char* ws, LAS unsigned char* lds, int tid) {
    LAS float* G1 = (LAS float*)lds;
    LAS float* G2 = G1 + 512;
    LAS float* vv = G2 + 512;
    LAS float* zz = vv + 2048;
    LAS float* P = zz + 2048;
    const float* w3 = in[I_PW3] + (size_t)L * 64 * 2048; const float* H2 = (const float*)(ws + WS_H2) + ((size_t)L * 4352 + 4096) * 64;
    const float* cw = in[I_HCW] + (size_t)L * 3 * 1536; const float* cb = in[I_HCB] + (size_t)L * 1536; const float* sk = in[I_SKIP] + (size_t)L * 2 * 512;
    const float a0 = cw[c], a1 = cw[1536 + c], a2 = cw[3072 + c], ab = cb[c];
    const float b0 = cw[512 + c], b1 = cw[1536 + 512 + c], b2 = cw[3072 + 512 + c], bb = cb[512 + c];
    const float v0 = cw[1024 + c], v1 = cw[1536 + 1024 + c], v2 = cw[3072 + 1024 + c], vb = cb[1024 + c];
    const float skip0 = sk[c], skip1 = sk[512 + c], delta = hy_delta(c);
    const bf16* UT = (const bf16*)(ws + WS_UT); bf16* YHT = (bf16*)(ws + WS_YHT);
    const bf16* x1r = UT + (size_t)c * R_ALL + T_LAT; const bf16* x2r = UT + (size_t)(512 + c) * R_ALL + T_LAT; const bf16* vr = UT + (size_t)(1024 + c) * R_ALL + T_LAT;
    __syncthreads();
    for (int idx = tid; idx < 1024; idx += NTHR) { const int od = idx >> 8, t = idx & 255; const float* row = H2 + (size_t)t * 64; float d = 0.f;
        for (int j = 0; j < 64; ++j) d += row[j] * w3[(size_t)j * 2048 + od * 512 + c];
        d *= expf(-((float)t / 255.f) * delta);
        LAS float* G = (od & 2) ? G2 : G1;
        if (od & 1) { if (t > 0) G[255 + t] = d; } else G[255 - t] = d; }
    for (int idx = tid; idx < 2048; idx += NTHR) { const int b = idx >> 8, t = idx & 255; vv[t * 8 + b] = sconv(vr + b * 256, t, 256, v0, v1, v2, vb); }
    __syncthreads();
    hyena_ctx_conv(G1, vv, P, tid);
    __syncthreads();
    for (int idx = tid; idx < 2048; idx += NTHR) { const int b = idx & 7, t = idx >> 3; const float y = P[t * 8 + b] + P[2048 + t * 8 + b];
        zz[t * 8 + b] = sconv(x1r + b * 256, t, 256, a0, a1, a2, ab) * (y + skip0 * vv[t * 8 + b]); }
    __syncthreads();
    hyena_ctx_conv(G2, zz, P, tid);
    __syncthreads();
    for (int idx = tid; idx < 2048; idx += NTHR) { const int b = idx & 7, t = idx >> 3; const float y = P[t * 8 + b] + P[2048 + t * 8 + b];
        YHT[(size_t)c * R_ALL + T_LAT + b * 256 + t] = (bf16)f2bf(sconv(x2r + b * 256, t, 256, b0, b1, b2, bb) * (y + skip1 * zz[t * 8 + b])); }
    __syncthreads();
}
__device__ __forceinline__ void phase_gather(int npan, unsigned char* ws, LAS unsigned char* lds, int wg, int tid) {
    LAS int* tot = (LAS int*)lds; LAS int* basew = tot + 64; LAS int* pstart = tot + 128; LAS int* part = tot + 256;
    const unsigned* hist = (const unsigned*)(ws + WS_HIST);
    __syncthreads();
    { const int e = tid & 63, w0 = tid >> 6; int t = 0, b = 0;
#pragma unroll 4
      for (int w = w0; w < npan; w += 8) { const int h = (int)hist[w * 64 + e]; t += h; b += (w < wg) ? h : 0; }
      part[w0 * 128 + e] = t; part[w0 * 128 + 64 + e] = b; }
    __syncthreads();
    if (tid < 64) { int t = 0, b = 0;
#pragma unroll
        for (int k = 0; k < 8; ++k) { t += part[k * 128 + tid]; b += part[k * 128 + 64 + tid]; }
        tot[tid] = t; basew[tid] = b; }
    __syncthreads();
    if (tid == 0) { int acc = 0; for (int e = 0; e < 64; ++e) { pstart[e] = acc; acc += (tot[e] + 255) / 256 * 256; } pstart[64] = acc; }
    __syncthreads();
    int* stok = (int*)(ws + WS_STOK);
    if (wg == 255 && tid < 64) { int* be = (int*)(ws + WS_BLKE); for (int b = pstart[tid] / 256; b < pstart[tid + 1] / 256; ++b) be[b] = tid; if (tid == 0) be[512] = pstart[64] / 256; }
    if (wg >= 192) { const int e = wg - 192; for (int s = pstart[e] + tot[e] + tid; s < pstart[e + 1]; s += NTHR) stok[s] = 0; }
    if (wg < npan && tid < 256) { const int tok = wg * 256 + tid;
        const int2 e = ((const int2*)(ws + WS_TOKE))[tok], r = ((const int2*)(ws + WS_TOKR))[tok];
        const int s0 = pstart[e.x] + basew[e.x] + r.x, s1 = pstart[e.y] + basew[e.y] + r.y;
        ((int2*)(ws + WS_TOKS))[tok] = make_int2(s0, s1); stok[s0] = tok; stok[s1] = tok; }
    __syncthreads();
}

constexpr int NPHASES = 27;
struct Args { const float* in[N_IN]; float* out; unsigned char* ws; int ph_lo, ph_hi; };
static_assert(sizeof(Args) == N_IN * 8 + 8 + 8 + 8, "Args has no padding");

__global__ void __launch_bounds__(NTHR, 2) fwd_kernel(Args args) {
    extern __shared__ __attribute__((aligned(16))) unsigned char lds_raw[];
    LAS unsigned char* lds = (LAS unsigned char*)lds_raw;
    volatile LAS unsigned* MISC = (volatile LAS unsigned*)(lds + MISC_OFF);
    const int tid0 = threadIdx.x; const int wave0 = __builtin_amdgcn_readfirstlane(tid0 >> 6);
    constexpr int G = 256, NGW = G * NWAVES;
    const int wg0 = blockIdx.x;
#define PH_IDS() int tid; asm volatile("v_mbcnt_lo_u32_b32 %0, -1, 0\n\tv_mbcnt_hi_u32_b32 %0, -1, %0\n\tv_lshl_or_b32 %0, %1, 6, %0" : "=&v"(tid) : "s"(wave0));     const int wg = opaque_u32(wg0); const int lane = tid & 63, wave = __builtin_amdgcn_readfirstlane(tid >> 6), gw = wg * NWAVES + wave; (void)lane; (void)gw; \
    unsigned char* ws = ws0 + (size_t)(unsigned)opaque_u32(0);     const InTab in{(LAS const unsigned long long*)(lds + PTAB_OFF)}; (void)in
    unsigned char* const ws0 = args.ws;
    for (int u = tid0; u < (LDS_BYTES - RING_BYTES) / 4; u += NTHR) ((LAS unsigned*)(lds + RING_BYTES))[u] = 0u;
    __syncthreads();
    if (tid0 == 0) { LAS unsigned long long* pt = (LAS unsigned long long*)(lds + PTAB_OFF);
#pragma unroll
        for (int i = 0; i < N_IN; ++i) pt[i] = (unsigned long long)(uintptr_t)args.in[i]; }
    __syncthreads();
    unsigned* ctl = (unsigned*)(ws0 + WS_CTL); (void)ctl;
#if MK_PER_PHASE
#define GRID_BAR() do { } while (0)
#else
    XcdBarrier bar = xcd_barrier_post(ctl + CW_BAR, MISC + 8, wave0);
#define GRID_BAR() xcd_barrier(bar)
#endif
    const int lo = args.ph_lo, hi = args.ph_hi;
#define IN(k) (lo <= (k) && (k) < hi)
#ifdef PROBE_MASK
    unsigned long long probe_t0 = __builtin_amdgcn_s_memrealtime();
#define SEAM(k) do { if (IN(k) && IN((k) + 1)) GRID_BAR(); { const unsigned long long t1_ = __builtin_amdgcn_s_memrealtime(); \
        if ((PROBE_MASK >> (k)) & 1ull) { const unsigned long long w_ = 4ull * (t1_ - probe_t0); while (__builtin_amdgcn_s_memrealtime() - t1_ < w_) __builtin_amdgcn_s_sleep(8); } \
        probe_t0 = __builtin_amdgcn_s_memrealtime(); } } while (0)
#else
#define SEAM(k) do { if (IN(k) && IN((k) + 1)) GRID_BAR(); } while (0)
#endif

    if (IN(0)) { PH_IDS();
        for (int u = gw; u < 768; u += NGW) mods_partial_unit(u, in, ws, lane);
        if (gw >= 768 && gw < 768 + 512) h2_rows((gw - 768) >> 8, (gw - 768) & 255, 256, in, ws, lane);
        for (int i = wg * NTHR + tid; i < 2048; i += G * NTHR) { const int v = i >> 5, j = i & 31; const double ang = (double)v * pow(10000.0, -(double)j / 32.0);
            ((float2*)(ws + WS_ROPE))[i] = make_float2((float)cos(ang), (float)sin(ang)); }
        { const float* rw = in[I_RW]; bf16* BTR = (bf16*)(ws + WS_BTR);
          for (int i = wg * NTHR + tid; i < 256 * 1024; i += G * NTHR) { const int row = i >> 10, k = i & 1023; BTR[i] = (bf16)(row < 64 ? f2bf(rw[(size_t)k * 64 + row]) : 0u); } }
        { const float* w3 = in[I_PW3]; bf16* W3S = (bf16*)(ws + WS_W3S);
          for (int i = wg * NTHR + tid; i < 2 * 2048 * 256; i += G * NTHR) { const int L = i >> 19, col = (i >> 8) & 2047, k = i & 255, j = k & 63, part = k >> 6;
              const float w = w3[((size_t)L * 64 + j) * 2048 + col]; const unsigned hi = f2bf(w); W3S[i] = (bf16)(part < 2 ? hi : part == 2 ? f2bf(w - bf2f(hi)) : 0u); } }
        LAS float* scr = (LAS float*)(lds + wave * 16896);
        for (int it = gw; it < 2 * SMALL_ITEMS; it += NGW) conv_small_item(it % SMALL_ITEMS, it / SMALL_ITEMS, in, ws, scr, lane);
        for (int it = gw; it < EXPERT_ITEMS; it += NGW) conv_expert_item(it, 0, in, ws, scr, lane);
    }
    SEAM(0);
    if (IN(1)) { PH_IDS();
        const float* P = (const float*)(ws + WS_MODP); float* M = (float*)(ws + WS_MODS);
        for (int i = wg * NTHR + tid; i < 2 * 9 * 6144; i += G * NTHR) { const int L = i / (9 * 6144), col = i % 6144; float s = in[I_BADA][L * 6144 + col];
            for (int ks = 0; ks < 16; ++ks) s += P[((size_t)(ks * 2 + L) * 9 + (i / 6144) % 9) * 6144 + col];
            M[i] = s; }
        { pg8::Gemm g{(const bf16*)(ws + WS_W3S), (const bf16*)(ws + WS_H2S), 2 * 2048, 2 * 4096, 256}; pg8::FiltOrder S{wg}; pg8::EpiFilt E{(float*)(ws + WS_FT)};
          __syncthreads(); pg8::gemm_phase<pg8::EpiFilt, pg8::FiltOrder, true, true>(lds, g, S, E, tid); }
    }
    SEAM(1);
    for (int L = 0; L < 2; ++L) {
        const int pb = 2 + 12 * L;
        const int nrows = L == 0 ? R_ALL : T_LAT;
        if (IN(pb + 0)) { PH_IDS();
            phase_norm1(L, in, ws, gw, NGW, lane);
            if (L == 1) {
                GRID_BAR();
                if (wg >= G - 16) { constexpr size_t TS = 512 * 1024; const int hx0 = (int)(WS_HX / TS), wa0 = (int)((WS_WSM + (size_t)L * WSM_LAYER + WSM_WINA) / TS), wu0 = (int)((WS_WSM + (size_t)L * WSM_LAYER + WSM_WINU) / TS);
                    pg8::Gemm g{(const bf16*)ws, (const bf16*)ws, 0, 0, DM}; pg8::CtxKVOrder S{hx0, wa0, wg - (G - 16)};
                    pg8::EpiGemm1 E{pg8::EpiQKVG{(bf16*)(ws + WS_Q), (bf16*)(ws + WS_KB), (bf16*)(ws + WS_VB), (bf16*)(ws + WS_G)}, pg8::EpiStoreBf16{(bf16*)(ws + WS_UT), R_ALL, 0x7fffffff}, hx0, wa0, wu0};
                    pg8::gemm_phase<pg8::EpiGemm1, pg8::CtxKVOrder, true, true>(lds, g, S, E, tid); }
                __syncthreads();
            }
            { const FftTw tw = fft_tw_init(tid); for (int c = wg; c < HYW; c += G) filter_fft_unit(c, L, in, ws, lds, tid, tw); }
            __syncthreads();
            if (L == 1 && wg < G - 16) { LAS float* scr = (LAS float*)(lds + wave * 16896); for (int it = gw; it < EXPERT_ITEMS; it += NGW - 16 * NWAVES) conv_expert_item(it, 1, in, ws, scr, lane); }
        }
        SEAM(pb + 0);
        if (IN(pb + 1)) { PH_IDS(); (void)tid; (void)wave;
            constexpr size_t TS = 512 * 1024;
            static_assert(WS_HX % TS == 0 && WS_WSM % TS == 0 && WSM_LAYER % TS == 0 && WSM_WINU % TS == 0, "GEMM1 tile space");
            const int hx0 = (int)(WS_HX / TS), wa0 = (int)((WS_WSM + (size_t)L * WSM_LAYER + WSM_WINA) / TS), wu0 = (int)((WS_WSM + (size_t)L * WSM_LAYER + WSM_WINU) / TS);
            pg8::Gemm g{(const bf16*)ws, (const bf16*)ws, 0, 0, DM}; pg8::Gemm1Order S; S.init(hx0, wa0, wu0, G, wg, L == 0 ? 136 : 128);
            pg8::EpiGemm1 E{pg8::EpiQKVG{(bf16*)(ws + WS_Q), (bf16*)(ws + WS_KB), (bf16*)(ws + WS_VB), (bf16*)(ws + WS_G)}, pg8::EpiStoreBf16{(bf16*)(ws + WS_UT), R_ALL, 0x7fffffff}, hx0, wa0, wu0};
            pg8::gemm_phase<pg8::EpiGemm1, pg8::Gemm1Order, true, true>(lds, g, S, E, tid);
        }
        SEAM(pb + 1);
        if (IN(pb + 2)) { PH_IDS();
            phase_kpost(L, in, ws, gw, NGW, lane);
            { volatile LAS unsigned* gcnt = (volatile LAS unsigned*)(lds + RING_BYTES + 2048); unsigned epoch = 0u;
              __syncthreads(); if (tid == 0) { gcnt[0] = 0u; gcnt[16] = 0u; } __syncthreads();
              for (int c = wg; c < HYW; c += G) hyena_unit(c, L, in, ws, lds, tid, gcnt, epoch);
              __syncthreads(); }
            if (L == 0) for (int c = wg; c < HYW; c += G) hyena_ctx_unit(c, L, in, ws, lds, tid);
        }
        SEAM(pb + 2);
        if (IN(pb + 3)) { { PH_IDS(); (void)tid; (void)wave;
            const int vcu = (G % 8 == 0) ? (wg % 8) * (G / 8) + wg / 8 : wg;
            const attn::bf16* Q = (const attn::bf16*)(ws + WS_Q); attn::bf16* OY = (attn::bf16*)(ws + WS_OY); const attn::bf16* KB = (const attn::bf16*)(ws + WS_KB); const attn::bf16* VB = (const attn::bf16*)(ws + WS_VB);
            const float* qnw = in[I_QNW] + L * 128; const float2* rope = (const float2*)(ws + WS_ROPE);
            __syncthreads();
            for (int u = vcu; u < 1024; u += G) {
                const int qb = u & 15, hg = (u >> 4) & 3, kvh = (u >> 6) & 1, b = u >> 7, h = kvh * 4 + hg;
                attn::attn_dense_body(Q + (size_t)(b * SEQ + qb * 256) * 1024 + h * 128, OY + (size_t)(b * SEQ + qb * 256) * 1536 + h * 128, KB + (size_t)b * SKV * 256 + kvh * 128, VB + (size_t)b * SKV * 256 + kvh * 128, SKV, (char*)lds_raw, qnw, rope, qb * 256, wave0);
            }
            if (L == 0) for (int u = vcu; u < 64; u += G) { const int h = u & 7, b = u >> 3, kvh = h >> 2;
                attn::attn_dense_body(Q + (size_t)(T_LAT + b * CL) * 1024 + h * 128, OY + (size_t)(T_LAT + b * CL) * 1536 + h * 128, KB + ((size_t)b * SKV + SEQ) * 256 + kvh * 128, VB + ((size_t)b * SKV + SEQ) * 256 + kvh * 128, CL, (char*)lds_raw, qnw, nullptr, 0, wave0); }
            }
            { PH_IDS(); (void)tid; phase_transpose(ws, lds, wave, gw, NGW, lane); }
        }
        SEAM(pb + 3);
        if (IN(pb + 4)) { PH_IDS(); (void)tid; (void)wave;
            pg8::Gemm g{(const bf16*)(ws + WS_OY), wsm(ws, L, WSM_WAP), nrows, DM, DM + HYW}; pg8::StaticOrder S; S.init(nrows, DM, G, wg);
            pg8::EpiMergeCat E{(bf16*)(ws + WS_MG), (const bf16*)(ws + WS_G)};
            pg8::gemm_phase<pg8::EpiMergeCat, pg8::StaticOrder, true, true>(lds, g, S, E, tid);
        }
        SEAM(pb + 4);
        if (IN(pb + 5)) { PH_IDS(); (void)tid; (void)wave;
            pg8::Gemm g{(const bf16*)(ws + WS_MG), wsm(ws, L, WSM_WOUT), nrows, DM, DM}; pg8::StaticOrder S; S.init(nrows, DM, G, wg);
            bf16* X = (bf16*)(ws + WS_X); const float* g1 = (const float*)(ws + WS_MODS) + (size_t)L * 9 * 6144 + 2 * 1024;
            if (L == 0) { pg8::EpiResid<false> E{(const void*)in[I_X], (const void*)in[I_CTX], X, g1}; pg8::gemm_phase<pg8::EpiResid<false>, pg8::StaticOrder, true, true>(lds, g, S, E, tid); }
            else { pg8::EpiResid<true> E{(const void*)X, (const void*)(X + (size_t)T_LAT * 1024), X, g1}; pg8::gemm_phase<pg8::EpiResid<true>, pg8::StaticOrder, true, true>(lds, g, S, E, tid); }
        }
        SEAM(pb + 5);
        if (IN(pb + 6)) { PH_IDS(); phase_norm2(L, nrows, in, ws, gw, NGW, lane); }
        SEAM(pb + 6);
        if (IN(pb + 7)) { PH_IDS(); (void)tid; (void)wave;
            pg8::Gemm g{(const bf16*)(ws + WS_HXS), (const bf16*)(ws + WS_BTR), nrows, 256, 1024}; pg8::StaticOrder S; S.init(nrows, 256, G, wg);
            pg8::EpiTopK E{in[I_RB], (int*)(ws + WS_TOKE), (float*)(ws + WS_TOKG), (int*)(ws + WS_TOKR), (unsigned*)(ws + WS_HIST)};
            pg8::gemm_phase<pg8::EpiTopK, pg8::StaticOrder, true, true>(lds, g, S, E, tid);
        }
        SEAM(pb + 7);
        if (IN(pb + 9)) { PH_IDS(); phase_gather(nrows / 256, ws, lds, wg, tid); }
        SEAM(pb + 9);
        if (IN(pb + 10)) { PH_IDS(); (void)tid; (void)wave;
            const int* be = (const int*)(ws + WS_BLKE); const int nblk = be[512];
            pg8::Gemm g{(const bf16*)(ws + WS_HXS), (const bf16*)(ws + WS_W13), nblk * 256, 1024, DM}; pg8::MoeGatherOrder S; S.init(nblk, be, G, wg, (const int*)(ws + WS_STOK), 2048);
            pg8::EpiSwiGLU E{(bf16*)(ws + WS_HMID)};
            pg8::gemm_phase<pg8::EpiSwiGLU, pg8::MoeGatherOrder, true, true>(lds, g, S, E, tid);
        }
        SEAM(pb + 10);
        if (IN(pb + 11)) { PH_IDS(); (void)tid; (void)wave;
            const int* be = (const int*)(ws + WS_BLKE); const int nblk = be[512];
            pg8::Gemm g{(const bf16*)(ws + WS_HMID), (const bf16*)(ws + WS_W2T), nblk * 256, 1024, EDIM}; pg8::MoeOrder S; S.init(nblk, be, G, wg);
            pg8::EpiStoreBf16 E{(bf16*)(ws + WS_Y), 1024, 3};
            pg8::gemm_phase<pg8::EpiStoreBf16, pg8::MoeOrder, true, true>(lds, g, S, E, tid);
        }
        SEAM(pb + 11);
    }
    if (IN(26)) { PH_IDS(); phase_final(in, args.out, ws, gw, NGW, lane); }
#undef IN
#undef SEAM
}

extern "C" void kernel_launch(void* const* d_in, const int* in_sizes, int n_in, void* d_out, int out_size, void* d_ws, size_t ws_size, hipStream_t stream) {
    static int grid = 0;
    if (grid == 0) {
        if (n_in != N_IN || in_sizes[0] != T_LAT * DM || out_size != T_LAT * DM || ws_size < WS_END) {
            fprintf(stderr, "kernel_launch: shape mismatch (n_in %d in0 %d out %d ws %zu, need ws >= %zu); nothing launched\n", n_in, n_in > 0 ? in_sizes[0] : -1, out_size, ws_size, (size_t)WS_END); grid = -1; return; }
        int dev = 0, cus = 0, per_cu = 0;
        if (hipGetDevice(&dev) != hipSuccess || hipDeviceGetAttribute(&cus, hipDeviceAttributeMultiprocessorCount, dev) != hipSuccess) { grid = -1; return; }
        if (hipFuncSetAttribute((const void*)fwd_kernel, hipFuncAttributeMaxDynamicSharedMemorySize, LDS_BYTES) != hipSuccess) { fprintf(stderr, "kernel_launch: hipFuncSetAttribute failed\n"); grid = -1; return; }
        if (hipOccupancyMaxActiveBlocksPerMultiprocessor(&per_cu, (const void*)fwd_kernel, NTHR, LDS_BYTES) != hipSuccess || per_cu < 1) fprintf(stderr, "kernel_launch: occupancy query says %d\n", per_cu);
        (void)hipGetLastError();
        if (cus < 256) { fprintf(stderr, "kernel_launch: %d CUs < 256; nothing launched\n", cus); grid = -1; return; }
        grid = 256;
    }
    if (grid < 0) return;
    (void)hipMemsetAsync((char*)d_ws + WS_CTL, 0, CTL_ZERO_BYTES, stream);
    Args a{};
    for (int i = 0; i < N_IN; ++i) a.in[i] = (const float*)d_in[i];
    a.out = (float*)d_out; a.ws = (unsigned char*)d_ws;
#if MK_PER_PHASE
    for (int p = 0; p < NPHASES; ++p) { a.ph_lo = p; a.ph_hi = p + 1; hipLaunchKernelGGL(fwd_kernel, dim3(grid), dim3(NTHR), LDS_BYTES, stream, a); }
#else
    a.ph_lo = 0; a.ph_hi = NPHASES; hipLaunchKernelGGL(fwd_kernel, dim3(grid), dim3(NTHR), LDS_BYTES, stream, a);
#endif
    const hipError_t le = hipPeekAtLastError();
    if (le != hipSuccess) fprintf(stderr, "kernel_launch: launch failed: %s\n", hipGetErrorName(le));
}
```

```cpp
#include <hip/hip_runtime.h>
#include <cstdio>
#include <cstdint>

#ifndef MK_PER_PHASE
#define MK_PER_PHASE 0
#endif

namespace pg8 {
#define PG8_LAS __attribute__((address_space(3)))
typedef unsigned short bf16_t;
typedef short bf16x8 __attribute__((ext_vector_type(8)));
typedef float f32x4 __attribute__((ext_vector_type(4)));
typedef unsigned u32x4 __attribute__((ext_vector_type(4)));
constexpr int BM = 256, BK = 64, HALF = 128, HTB = HALF * BK * 2  , STAGE_BYTES = 8 * HTB, NXCD = 8, WGM = 8;

__host__ __device__ __forceinline__ int lds_byte(int r, int c) { const int st = (r >> 4) * 2 + (c >> 5), rr = r & 15, cc = c & 31, ob = rr * 64 + cc * 2; return st * 1024 + (ob ^ (((ob >> 9) & 1) << 5)); }
__host__ __device__ __forceinline__ void stage_rc(int b, int& R, int& C) { const int st = b / 1024, sb = b % 1024, swz = sb ^ (((sb >> 9) & 1) << 5); R = (st >> 1) * 16 + swz / 64; C = (st & 1) * 32 + (swz % 64) / 2; }
__host__ __device__ __forceinline__ int perm32(int rho) { const int n = rho >> 4, i = rho & 15; return 8 * (i >> 2) + 4 * n + (i & 3); }

struct Unit { int pm, pn; };
struct Gemm { const bf16_t* A; const bf16_t* Bt; int M, N, K; };

struct StaticOrder {
    static constexpr bool GATHER = false; __device__ __forceinline__ const int* rowtab() const { return nullptr; } __device__ __forceinline__ int lda_bytes() const { return 0; }
    int nM, nN, nwg, G, c;
    __host__ __device__ void init(int M, int N, int G_, int c_) { nM = M / BM; nN = N / BM; nwg = nM * nN; G = G_; c = c_; }
    __host__ __device__ bool next(int i, Unit& u) const {
        const long L = (long)i * G + c; if (L >= nwg) return false;
        int wgid = (int)L; { const int q = nwg / NXCD, r = nwg % NXCD, xcd = wgid % NXCD, off = wgid / NXCD; wgid = (xcd < r ? xcd * (q + 1) : r * (q + 1) + (xcd - r) * q) + off; }
        const int nig = WGM * nN, gid = wgid / nig, fm = gid * WGM, gsz = (nM - fm) < WGM ? (nM - fm) : WGM;
        u.pm = fm + ((wgid % nig) % gsz); u.pn = (wgid % nig) / gsz; return true;
    }
    __device__ __forceinline__ void a_ready(const Unit&) const {}
    __device__ __forceinline__ void done(const Unit&) const {}
};

__device__ __forceinline__ unsigned cvt_pk_bf16(float lo, float hi) { unsigned r; asm volatile("v_cvt_pk_bf16_f32 %0, %1, %2" : "=v"(r) : "v"(lo), "v"(hi)); return r; }
typedef float f32x2 __attribute__((ext_vector_type(2)));
__device__ __forceinline__ float bf2f(unsigned b) { return __uint_as_float(b << 16); }
__device__ __forceinline__ float sigm(float x) { return __builtin_amdgcn_rcpf(1.f + __builtin_amdgcn_exp2f(-1.4426950408889634f * x)); }
__device__ __forceinline__ u32x4 pack8(const f32x4& v0, const f32x4& v1) { u32x4 w; w.x = cvt_pk_bf16(v0[0], v0[1]); w.y = cvt_pk_bf16(v0[2], v0[3]); w.z = cvt_pk_bf16(v1[0], v1[1]); w.w = cvt_pk_bf16(v1[2], v1[3]); return w; }
__device__ __forceinline__ void unpack8(const u32x4& w, f32x4& v0, f32x4& v1) {
    v0[0] = bf2f(w.x & 0xffffu); v0[1] = bf2f(w.x >> 16); v0[2] = bf2f(w.y & 0xffffu); v0[3] = bf2f(w.y >> 16);
    v1[0] = bf2f(w.z & 0xffffu); v1[1] = bf2f(w.z >> 16); v1[2] = bf2f(w.w & 0xffffu); v1[3] = bf2f(w.w >> 16); }

struct EpiStoreBf16 {
    static constexpr int MIDK = 0; static constexpr bool PERM = true, AFTER_DRAIN = false;
    bf16_t* O; int ldc; int pn_mask;
    __device__ __forceinline__ void operator()(const f32x4 (&acc)[2][2][4][2], const Unit& u, int wr, int wc, int fr, int fq) const {
        bf16_t* base = O + (size_t)(u.pm * BM + wr * 64 + fr) * ldc + (u.pn & pn_mask) * BM + wc * 32 + 8 * fq;
#pragma unroll
        for (int ai = 0; ai < 2; ++ai)
#pragma unroll
            for (int m = 0; m < 4; ++m) { bf16_t* rowp = base + (size_t)(ai * HALF + m * 16) * ldc;
#pragma unroll
                for (int bj = 0; bj < 2; ++bj) *(u32x4*)(rowp + bj * HALF) = pack8(acc[ai][bj][m][0], acc[ai][bj][m][1]); }
    }
};
struct EpiQKVG {
    static constexpr int MIDK = 0; static constexpr bool PERM = true, AFTER_DRAIN = false;
    bf16_t *Q, *KB, *VB, *G;
    __device__ __forceinline__ void operator()(const f32x4 (&acc)[2][2][4][2], const Unit& u, int wr, int wc, int fr, int fq) const {
        const int pm = u.pm, pn = u.pn; bf16_t* base; int ldc; bool act = false;
        if (pn < 4) { base = Q + (size_t)(pm * BM) * 1024 + pn * BM; ldc = 1024; }
        else if (pn < 6) { const int kv0 = pm < 128 ? (pm >> 4) * 4352 + (pm & 15) * 256 : (pm - 128) * 4352 + 4096; base = (pn == 4 ? KB : VB) + (size_t)kv0 * 256; ldc = 256; }
        else { base = G + (size_t)(pm * BM) * 2048 + (pn - 6) * BM; ldc = 2048; act = true; }
        base += (size_t)(wr * 64 + fr) * ldc + wc * 32 + 8 * fq;
#pragma unroll
        for (int ai = 0; ai < 2; ++ai)
#pragma unroll
            for (int m = 0; m < 4; ++m) { bf16_t* rowp = base + (size_t)(ai * HALF + m * 16) * ldc;
#pragma unroll
                for (int bj = 0; bj < 2; ++bj) { f32x4 v0 = acc[ai][bj][m][0], v1 = acc[ai][bj][m][1];
                    if (act) {
#pragma unroll
                        for (int i = 0; i < 4; ++i) { v0[i] = sigm(v0[i]); v1[i] = sigm(v1[i]); } }
                    *(u32x4*)(rowp + bj * HALF) = pack8(v0, v1); } }
    }
};
struct EpiMergeCat {
    static constexpr int MIDK = 16; static constexpr bool PERM = true, AFTER_DRAIN = false;
    bf16_t* MG; const bf16_t* G;
    __device__ __forceinline__ void mid(f32x4 (&acc)[2][2][4][2], const Unit& u, int wr, int wc, int fr, int fq) const {
        asm volatile("" : "+v"(fr), "+v"(fq));
        const int row0 = u.pm * BM + wr * 64 + fr, col0 = u.pn * BM + wc * 32 + 8 * fq;
#pragma unroll
        for (int ai = 0; ai < 2; ++ai) {
            u32x4 ga[4][2], gh[4][2];
#pragma unroll
            for (int m = 0; m < 4; ++m)
#pragma unroll
                for (int bj = 0; bj < 2; ++bj) { const bf16_t* gp = G + (size_t)(row0 + ai * HALF + m * 16) * 2048 + col0 + bj * HALF; ga[m][bj] = *(const u32x4*)gp; gh[m][bj] = *(const u32x4*)(gp + 1024); }
#pragma unroll
            for (int m = 0; m < 4; ++m) asm volatile("" : "+v"(ga[m][0]), "+v"(ga[m][1]), "+v"(gh[m][0]), "+v"(gh[m][1]));
#pragma unroll
            for (int m = 0; m < 4; ++m)
#pragma unroll
                for (int bj = 0; bj < 2; ++bj) { f32x4 a0, a1, h0, h1; unpack8(ga[m][bj], a0, a1); unpack8(gh[m][bj], h0, h1);
#pragma unroll
                    for (int i = 0; i < 4; ++i) { acc[ai][bj][m][0][i] *= a0[i] * __builtin_amdgcn_rcpf(fmaxf(h0[i], 1e-30f)); acc[ai][bj][m][1][i] *= a1[i] * __builtin_amdgcn_rcpf(fmaxf(h1[i], 1e-30f)); } }
            asm volatile("" ::: "memory"); }
    }
    __device__ __forceinline__ void operator()(const f32x4 (&acc)[2][2][4][2], const Unit& u, int wr, int wc, int fr, int fq) const {
        asm volatile("" : "+v"(fr), "+v"(fq));
        const int row0 = u.pm * BM + wr * 64 + fr, col0 = u.pn * BM + wc * 32 + 8 * fq;
#pragma unroll
        for (int ai = 0; ai < 2; ++ai) {
            u32x4 gh[4][2];
#pragma unroll
            for (int m = 0; m < 4; ++m)
#pragma unroll
                for (int bj = 0; bj < 2; ++bj) gh[m][bj] = *(const u32x4*)(G + (size_t)(row0 + ai * HALF + m * 16) * 2048 + 1024 + col0 + bj * HALF);
#pragma unroll
            for (int m = 0; m < 4; ++m) asm volatile("" : "+v"(gh[m][0]), "+v"(gh[m][1]));
#pragma unroll
            for (int m = 0; m < 4; ++m) { const size_t row = (size_t)(row0 + ai * HALF + m * 16);
#pragma unroll
                for (int bj = 0; bj < 2; ++bj) { const int col = col0 + bj * HALF; f32x4 h0, h1; unpack8(gh[m][bj], h0, h1);
#pragma unroll
                    for (int i = 0; i < 4; ++i) { h0[i] = fmaxf(h0[i], 1e-30f); h1[i] = fmaxf(h1[i], 1e-30f); }
                    *(u32x4*)(MG + row * 1024 + col) = pack8(acc[ai][bj][m][0] * h0, acc[ai][bj][m][1] * h1); } }
            asm volatile("" ::: "memory"); }
    }
};
template <bool BASE_BF16> struct EpiResid {
    static constexpr int MIDK = 0; static constexpr bool PERM = true, AFTER_DRAIN = false;
    const void* base_lat; const void* base_ctx; bf16_t* X; const float* g1;
    __device__ __forceinline__ void operator()(const f32x4 (&acc)[2][2][4][2], const Unit& u, int wr, int wc, int fr, int fq) const {
        const int pm = u.pm, row0 = pm * BM + wr * 64 + fr, col0 = u.pn * BM + wc * 32 + 8 * fq;
        const float* gp = g1 + (size_t)(pm < 128 ? (pm >> 4) : 8) * 6144 + col0;
        const size_t boff = pm < 128 ? (size_t)row0 * 1024 + col0 : (size_t)(row0 - 32768) * 1024 + col0; const void* bsrc = pm < 128 ? base_lat : base_ctx;
        bf16_t* xp = X + (size_t)row0 * 1024 + col0;
        f32x4 gv[2][2];
#pragma unroll
        for (int bj = 0; bj < 2; ++bj)
#pragma unroll
            for (int n = 0; n < 2; ++n) gv[bj][n] = *(const f32x4*)(gp + bj * HALF + n * 4);
#pragma unroll
        for (int ai = 0; ai < 2; ++ai)
#pragma unroll
            for (int m = 0; m < 4; ++m) { const size_t ro = (size_t)(ai * HALF + m * 16) * 1024;
#pragma unroll
                for (int bj = 0; bj < 2; ++bj) { f32x4 b0, b1;
                    if (BASE_BF16) { const u32x4 w = *(const u32x4*)((const bf16_t*)bsrc + boff + ro + bj * HALF); unpack8(w, b0, b1); }
                    else { const float* bp = (const float*)bsrc + boff + ro + bj * HALF; b0 = *(const f32x4*)bp; b1 = *(const f32x4*)(bp + 4); }
                    *(u32x4*)(xp + ro + bj * HALF) = pack8(b0 + gv[bj][0] * acc[ai][bj][m][0], b1 + gv[bj][1] * acc[ai][bj][m][1]); } }
    }
};
struct EpiLogits {
    static constexpr int MIDK = 0; static constexpr bool PERM = false, AFTER_DRAIN = false;
    float* LOG;
    __device__ __forceinline__ void operator()(const f32x4 (&acc)[2][2][4][2], const Unit& u, int wr, int wc, int fr, int fq) const {
        float* base = LOG + (size_t)(u.pm * BM + wr * 64 + fr) * 128 + wc * 32 + 4 * fq;
#pragma unroll
        for (int ai = 0; ai < 2; ++ai)
#pragma unroll
            for (int m = 0; m < 4; ++m)
#pragma unroll
                for (int n = 0; n < 2; ++n) *(f32x4*)(base + (size_t)(ai * HALF + m * 16) * 128 + n * 16) = acc[ai][0][m][n];
    }
};
struct EpiTopK {
    static constexpr int MIDK = 0; static constexpr bool PERM = false, AFTER_DRAIN = true;
    const float* rb; int* toke; float* tokg; int* tokr; unsigned* hist;
    __device__ __forceinline__ void fused(f32x4 (&acc)[2][2][4][2], const Unit& u, int wr, int wc, int fr, int fq, PG8_LAS unsigned char* lds, int wid, int lane) const {
        PG8_LAS float* Lg = (PG8_LAS float*)lds; PG8_LAS unsigned* lh = (PG8_LAS unsigned*)(lds + 256 * 132 * 4);
        const int tid = wid * 64 + lane;
        if (tid < 64) lh[tid] = 0u;
#pragma unroll
        for (int ai = 0; ai < 2; ++ai)
#pragma unroll
            for (int m = 0; m < 4; ++m)
#pragma unroll
                for (int n = 0; n < 2; ++n) *(PG8_LAS f32x4*)(Lg + (ai * HALF + wr * 64 + m * 16 + fr) * 132 + wc * 32 + n * 16 + 4 * fq) = acc[ai][0][m][n];
        asm volatile("s_waitcnt lgkmcnt(0)" ::: "memory"); __builtin_amdgcn_s_barrier(); asm volatile("" ::: "memory");
        if (tid < 256) {
            const PG8_LAS float* lg = Lg + tid * 132; const int tok = u.pm * BM + tid;
            float best = -1e30f; int gsel = 0;
#pragma unroll
            for (int g = 0; g < 8; ++g) { float m1 = -1e30f, m2 = -1e30f;
#pragma unroll
                for (int j = 0; j < 8; ++j) { const int e = g * 8 + j; const float v = 1.f / (1.f + expf(-(lg[e] + lg[64 + e]))) + rb[e];
                    if (v > m1) { m2 = m1; m1 = v; } else if (v > m2) m2 = v; }
                const float gs = m1 + m2; if (gs > best) { best = gs; gsel = g; } }
            float sc[8], bi[8];
#pragma unroll
            for (int j = 0; j < 8; ++j) { const int e = gsel * 8 + j; sc[j] = 1.f / (1.f + expf(-(lg[e] + lg[64 + e]))); bi[j] = sc[j] + rb[e]; }
            int i1 = 0; float bm = bi[0], s1 = sc[0];
#pragma unroll
            for (int j = 1; j < 8; ++j) if (bi[j] > bm) { bm = bi[j]; i1 = j; s1 = sc[j]; }
            int i2 = -1; float bm2 = -1e30f, s2 = 0.f;
#pragma unroll
            for (int j = 0; j < 8; ++j) if (j != i1 && bi[j] > bm2) { bm2 = bi[j]; i2 = j; s2 = sc[j]; }
            const int e1 = gsel * 8 + i1, e2 = gsel * 8 + i2; const float inv = 1.f / (s1 + s2);
            const unsigned r1 = __hip_atomic_fetch_add(lh + e1, 1u, __ATOMIC_RELAXED, __HIP_MEMORY_SCOPE_WORKGROUP), r2 = __hip_atomic_fetch_add(lh + e2, 1u, __ATOMIC_RELAXED, __HIP_MEMORY_SCOPE_WORKGROUP);
            toke[2 * tok] = e1; toke[2 * tok + 1] = e2; tokg[2 * tok] = s1 * inv; tokg[2 * tok + 1] = s2 * inv; tokr[2 * tok] = (int)r1; tokr[2 * tok + 1] = (int)r2;
        }
        asm volatile("s_waitcnt lgkmcnt(0)" ::: "memory"); __builtin_amdgcn_s_barrier(); asm volatile("" ::: "memory");
        if (tid < 64) hist[u.pm * 64 + tid] = lh[tid];
    }
};
struct EpiSwiGLU {
    static constexpr int MIDK = 0; static constexpr bool PERM = true, AFTER_DRAIN = false;
    bf16_t* H;
    __device__ __forceinline__ void operator()(const f32x4 (&acc)[2][2][4][2], const Unit& u, int wr, int wc, int fr, int fq) const {
        bf16_t* base = H + (size_t)(u.pm * BM + wr * 64 + fr) * 512 + (u.pn & 3) * 128 + wc * 32 + 8 * fq;
#pragma unroll
        for (int ai = 0; ai < 2; ++ai)
#pragma unroll
            for (int m = 0; m < 4; ++m) { f32x4 v0, v1;
#pragma unroll
                for (int i = 0; i < 4; ++i) { const float a0 = acc[ai][0][m][0][i], a1 = acc[ai][0][m][1][i];
                    v0[i] = a0 * sigm(a0) * acc[ai][1][m][0][i]; v1[i] = a1 * sigm(a1) * acc[ai][1][m][1][i]; }
                *(u32x4*)(base + (size_t)(ai * HALF + m * 16) * 512) = pack8(v0, v1); }
    }
};
struct Gemm1Order {
    static constexpr bool GATHER = false; __device__ __forceinline__ const int* rowtab() const { return nullptr; } __device__ __forceinline__ int lda_bytes() const { return 0; }
    StaticOrder a, b; int hx0, wa0, wu0, nA, nB, G, c;
    __device__ __forceinline__ void init(int hx0_, int wa0_, int wu0_, int G_, int c_, int P) { hx0 = hx0_; wa0 = wa0_; wu0 = wu0_; G = G_; c = c_; nA = P * 14; nB = 6 * P;
        a.init(P * 256, 14 * 256, 1, 0); b.init(6 * 256, P * 256, 1, 0); }
    __device__ __forceinline__ bool next(int i, Unit& u) const { const int L = i * G + c; if (L >= nA + nB) return false; Unit t;
        if (L < nA) { a.next(L, t); u.pm = hx0 + t.pm; u.pn = wa0 + t.pn; } else { b.next(L - nA, t); u.pm = wu0 + t.pm; u.pn = hx0 + t.pn; } return true; }
    __device__ __forceinline__ void a_ready(const Unit&) const {}
    __device__ __forceinline__ void done(const Unit&) const {}
};
struct CtxKVOrder {
    static constexpr bool GATHER = false; __device__ __forceinline__ const int* rowtab() const { return nullptr; } __device__ __forceinline__ int lda_bytes() const { return 0; }
    int hx0, wa0, c;
    __device__ __forceinline__ bool next(int i, Unit& u) const { if (i > 0 || c < 0 || c >= 16) return false; u.pm = hx0 + 128 + (c >> 1); u.pn = wa0 + 4 + (c & 1); return true; }
    __device__ __forceinline__ void a_ready(const Unit&) const {}
    __device__ __forceinline__ void done(const Unit&) const {}
};
struct EpiGemm1 {
    static constexpr int MIDK = 0; static constexpr bool PERM = true, AFTER_DRAIN = false;
    EpiQKVG qk; EpiStoreBf16 ut; int hx0, wa0, wu0;
    __device__ __forceinline__ void operator()(const f32x4 (&acc)[2][2][4][2], const Unit& u, int wr, int wc, int fr, int fq) const {
        if (u.pm >= hx0) { Unit t; t.pm = u.pm - hx0; t.pn = u.pn - wa0; qk(acc, t, wr, wc, fr, fq); }
        else { Unit t; t.pm = u.pm - wu0; t.pn = u.pn - hx0; ut(acc, t, wr, wc, fr, fq); }
    }
};
struct FiltOrder {
    static constexpr bool GATHER = false; __device__ __forceinline__ const int* rowtab() const { return nullptr; } __device__ __forceinline__ int lda_bytes() const { return 0; }
    int c;
    __device__ __forceinline__ bool next(int i, Unit& u) const { if (i > 0 || c >= 256) return false; const int L = c >> 7, w = c & 127; u.pm = L * 8 + (w >> 4); u.pn = L * 16 + (w & 15); return true; }
    __device__ __forceinline__ void a_ready(const Unit&) const {}
    __device__ __forceinline__ void done(const Unit&) const {}
};
struct EpiFilt {
    static constexpr int MIDK = 0; static constexpr bool PERM = false, AFTER_DRAIN = false;
    float* F;
    __device__ __forceinline__ void operator()(const f32x4 (&acc)[2][2][4][2], const Unit& u, int wr, int wc, int fr, int fq) const {
        const int L = u.pm >> 3, col0 = (u.pm & 7) * BM + wr * 64 + fr, t0 = (u.pn & 15) * BM + wc * 32 + 4 * fq;
        float* base = F + ((size_t)L * 2048 + col0) * 4096 + t0;
#pragma unroll
        for (int ai = 0; ai < 2; ++ai)
#pragma unroll
            for (int m = 0; m < 4; ++m) { const int col = col0 + ai * HALF + m * 16; const float dl = -(3.070113457325394f + (float)(col & 511) * 0.024032199274562772f) * (1.4426950408889634f / 4095.f);
#pragma unroll
                for (int bj = 0; bj < 2; ++bj)
#pragma unroll
                    for (int n = 0; n < 2; ++n) { const int t = t0 + bj * HALF + n * 16; f32x4 w;
#pragma unroll
                        for (int q = 0; q < 4; ++q) w[q] = __builtin_amdgcn_exp2f((float)(t + q) * dl);
                        *(f32x4*)(base + (size_t)(ai * HALF + m * 16) * 4096 + bj * HALF + n * 16) = acc[ai][bj][m][n] * w; } }
    }
};
template <bool GATHER_> struct MoeOrderT {
    static constexpr bool GATHER = GATHER_;
    int nunits, G, c; const int* blk_e; const int* rows; int lda_b;
    __device__ __forceinline__ const int* rowtab() const { return rows; } __device__ __forceinline__ int lda_bytes() const { return lda_b; }
    __device__ __forceinline__ void init(int nblk, const int* be, int G_, int c_, const int* rows_ = nullptr, int lda_b_ = 0) { nunits = nblk * 4; blk_e = be; G = G_; c = c_; rows = rows_; lda_b = lda_b_; }
    __device__ __forceinline__ bool next(int i, Unit& u) const { const int x = c & 7, s = c >> 3, blk = 64 * i + 8 * x + (s >> 2); if (blk * 4 >= nunits) return false; u.pm = blk; u.pn = blk_e[blk] * 4 + (s & 3); return true; }
    __device__ __forceinline__ void a_ready(const Unit&) const {}
    __device__ __forceinline__ void done(const Unit&) const {}
};
typedef MoeOrderT<false> MoeOrder;
typedef MoeOrderT<true> MoeGatherOrder;

template <class Epi, class Sched, bool ALIGN_EPI = false, bool SP2 = false>
__device__ __forceinline__ void gemm_phase(PG8_LAS unsigned char* lds, const Gemm g, const Sched& S, const Epi& E, int tid_in) {
    int tid = tid_in; asm volatile("" : "+v"(tid));
    const int wid = __builtin_amdgcn_readfirstlane(tid >> 6), lane = tid & 63, wr = wid >> 2, wc = wid & 3, fr = lane & 15, fq = lane >> 4;
    const int K = g.K, nt = K / BK;
    constexpr bool GATHER = Sched::GATHER;
    unsigned vAc[2][2], vAn[2][2], voffB[2]; int RA[2], CA2[2];
#pragma unroll
    for (int i = 0; i < 2; ++i) { int R, C; stage_rc(tid * 16 + i * 8192, R, C); const int Rb = Epi::PERM ? ((R & ~31) + perm32(R & 31)) : R;
        RA[i] = R; CA2[i] = C * 2; voffB[i] = (unsigned)(Rb * K + C) * 2u;
#pragma unroll
        for (int h = 0; h < 2; ++h) { vAc[h][i] = (unsigned)((R + h * HALF) * K + C) * 2u; vAn[h][i] = vAc[h][i]; } }
    PG8_LAS int* gtab = (PG8_LAS int*)(lds + STAGE_BYTES);
#define PG8_GVOFF(dst, ui_) do { _Pragma("unroll") for (int _h = 0; _h < 2; ++_h) _Pragma("unroll") for (int _i = 0; _i < 2; ++_i) \
        dst[_h][_i] = (unsigned)gtab[(ui_) * 256 + _h * HALF + RA[_i]] * (unsigned)S.lda_bytes() + (unsigned)CA2[_i]; } while (0)
    const size_t kstep = (size_t)(BK * 2);
    const size_t hstep = (size_t)HALF * K * 2;
    const size_t tstep = 2 * hstep;
    const unsigned ldsw = (unsigned)wid * 1024u;
    const int aoff = lds_byte(wr * 64 + fr, fq * 8), boff = lds_byte(wc * 32 + fr, fq * 8);
#define PG8_SA(b, h) (((b) * 2 + (h)) * HTB)
#define PG8_SB(b, h) ((4 + (b) * 2 + (h)) * HTB)
#define PG8_STAGE(bufoff, gbase, voff) do { _Pragma("unroll") for (int _i = 0; _i < 2; ++_i) \
        __builtin_amdgcn_global_load_lds((const unsigned*)((const char*)(gbase) + (voff)[_i]), (PG8_LAS unsigned*)(lds + (bufoff) + ldsw + _i * 8192), 16, 0, 0); } while (0)
#define PG8_LDA(dst, b, h) do { _Pragma("unroll") for (int m = 0; m < 4; ++m) _Pragma("unroll") for (int k = 0; k < 2; ++k) dst[m][k] = *(const PG8_LAS bf16x8*)(lds + PG8_SA(b, h) + aoff + m * 2048 + k * 1024); } while (0)
#define PG8_LDB(dst, b, h) do { _Pragma("unroll") for (int n = 0; n < 2; ++n) _Pragma("unroll") for (int k = 0; k < 2; ++k) dst[n][k] = *(const PG8_LAS bf16x8*)(lds + PG8_SB(b, h) + boff + n * 2048 + k * 1024); } while (0)
#define PG8_MMA(ai, bj, At, Bt) do { __builtin_amdgcn_s_setprio(1); _Pragma("unroll") for (int m = 0; m < 4; ++m) _Pragma("unroll") for (int n = 0; n < 2; ++n) _Pragma("unroll") for (int k = 0; k < 2; ++k) \
        acc[ai][bj][m][n] = __builtin_amdgcn_mfma_f32_16x16x32_bf16(Bt[n][k], At[m][k], acc[ai][bj][m][n], 0, 0, 0); __builtin_amdgcn_s_setprio(0); } while (0)
#define PG8_WAIT_V(n) asm volatile("s_waitcnt vmcnt(" #n ")" ::: "memory")
#define PG8_WAIT_L(n) asm volatile("s_waitcnt lgkmcnt(" #n ")" ::: "memory")
#define PG8_BAR __builtin_amdgcn_s_barrier()
#define PG8_SCHED __builtin_amdgcn_sched_barrier(0)
    Unit cur, nxt; int ui = 0;
    if (!S.next(0, cur)) return;
    f32x4 acc[2][2][4][2];
#pragma unroll
    for (int a = 0; a < 2; ++a)
#pragma unroll
        for (int b = 0; b < 2; ++b)
#pragma unroll
            for (int m = 0; m < 4; ++m)
#pragma unroll
                for (int n = 0; n < 2; ++n) acc[a][b][m][n] = (f32x4){0.f, 0.f, 0.f, 0.f};
    bf16x8 At[4][2], B0[2][2], B1[2][2];
    const char* cA = (const char*)g.A + (GATHER ? (size_t)0 : (size_t)cur.pm * tstep); const char* cB = (const char*)g.Bt + (size_t)cur.pn * tstep;
    if constexpr (GATHER) {
        { Unit uu; for (int i = 0; S.next(i, uu); ++i) if (tid < 256) gtab[i * 256 + tid] = S.rowtab()[uu.pm * 256 + tid]; }
        asm volatile("s_waitcnt vmcnt(0) lgkmcnt(0)" ::: "memory"); __builtin_amdgcn_s_barrier(); asm volatile("" ::: "memory");
        PG8_GVOFF(vAc, 0);
    }
    S.a_ready(cur);
    if constexpr (SP2) {
        PG8_STAGE(PG8_SB(0, 0), cB, voffB); PG8_STAGE(PG8_SB(0, 1), cB + hstep, voffB); PG8_STAGE(PG8_SA(0, 0), cA, vAc[0]); PG8_STAGE(PG8_SA(0, 1), cA, vAc[1]);
        if (wr == 1) PG8_BAR;
        PG8_WAIT_V(2); PG8_BAR;
        PG8_STAGE(PG8_SB(1, 0), cB + kstep, voffB); PG8_STAGE(PG8_SA(1, 0), cA + kstep, vAc[0]); PG8_STAGE(PG8_SB(1, 1), cB + hstep + kstep, voffB);
        PG8_WAIT_V(6); PG8_BAR;
    } else {
        PG8_STAGE(PG8_SB(0, 0), cB, voffB); PG8_STAGE(PG8_SA(0, 0), cA, vAc[0]); PG8_STAGE(PG8_SB(0, 1), cB + hstep, voffB); PG8_STAGE(PG8_SA(0, 1), cA, vAc[1]);
        if (wr == 1) PG8_BAR;
        PG8_WAIT_V(4); PG8_BAR;
        PG8_STAGE(PG8_SB(1, 0), cB + kstep, voffB); PG8_STAGE(PG8_SA(1, 0), cA + kstep, vAc[0]); PG8_STAGE(PG8_SB(1, 1), cB + hstep + kstep, voffB);
        PG8_WAIT_V(6); PG8_BAR;
    }
    for (;;) {
        const bool has_next = S.next(ui + 1, nxt);
        const char* nA = has_next ? (const char*)g.A + (GATHER ? (size_t)0 : (size_t)nxt.pm * tstep) : cA; const char* nB = has_next ? (const char*)g.Bt + (size_t)nxt.pn * tstep : cB;
        if constexpr (GATHER) { if (has_next) PG8_GVOFF(vAn, ui + 1); else { _Pragma("unroll") for (int _h = 0; _h < 2; ++_h) _Pragma("unroll") for (int _i = 0; _i < 2; ++_i) vAn[_h][_i] = vAc[_h][_i]; } }
        for (int seg = 0; seg < (Epi::MIDK > 0 ? 2 : 1); ++seg) {
        const int t_lo = (Epi::MIDK > 0 && seg == 1) ? Epi::MIDK : 0, t_hi = (Epi::MIDK > 0 && seg == 0) ? Epi::MIDK : nt;
        if constexpr (Epi::MIDK > 0) { if (seg == 1) E.mid(acc, cur, wr, wc, fr, fq); }
        for (int t = t_lo; t < t_hi; t += 2) {
            const bool last = (t == nt - 2);
            unsigned vAl[2][2];
#pragma unroll
            for (int _h = 0; _h < 2; ++_h)
#pragma unroll
                for (int _i = 0; _i < 2; ++_i) vAl[_h][_i] = (GATHER && last) ? vAn[_h][_i] : vAc[_h][_i];
            const char* a1 = cA + (size_t)(t + 1) * kstep;
            const char* a2 = last ? nA : cA + (size_t)(t + 2) * kstep; const char* b2 = last ? nB : cB + (size_t)(t + 2) * kstep;
            const char* a3 = a2 + kstep; const char* b3 = b2 + kstep;
            if (last && has_next) S.a_ready(nxt);
            if constexpr (SP2) {
            PG8_LDB(B0, 0, 0); PG8_LDB(B1, 0, 1); PG8_SCHED; PG8_LDA(At, 0, 0); PG8_STAGE(PG8_SA(1, 1), a1, vAc[1]);
            PG8_WAIT_V(8); PG8_WAIT_L(0); PG8_BAR; PG8_MMA(0, 0, At, B0); PG8_MMA(0, 1, At, B1); PG8_BAR; PG8_SCHED;
            PG8_LDA(At, 0, 1); PG8_STAGE(PG8_SB(0, 0), b2, voffB); PG8_STAGE(PG8_SB(0, 1), b2 + hstep, voffB); PG8_STAGE(PG8_SA(0, 0), a2, vAl[0]);
            PG8_WAIT_V(8); PG8_WAIT_L(0); PG8_BAR; PG8_MMA(1, 0, At, B0); PG8_MMA(1, 1, At, B1); PG8_BAR; PG8_SCHED;
            PG8_LDB(B0, 1, 0); PG8_LDB(B1, 1, 1); PG8_SCHED; PG8_LDA(At, 1, 0); PG8_STAGE(PG8_SA(0, 1), a2, vAl[1]);
            PG8_WAIT_V(8); PG8_WAIT_L(0); PG8_BAR; PG8_MMA(0, 0, At, B0); PG8_MMA(0, 1, At, B1); PG8_BAR; PG8_SCHED;
            PG8_LDA(At, 1, 1); PG8_STAGE(PG8_SB(1, 0), b3, voffB); PG8_STAGE(PG8_SB(1, 1), b3 + hstep, voffB); PG8_STAGE(PG8_SA(1, 0), a3, vAl[0]);
            PG8_WAIT_V(8); PG8_WAIT_L(0); PG8_BAR; PG8_MMA(1, 0, At, B0); PG8_MMA(1, 1, At, B1); PG8_BAR; PG8_SCHED;
            } else {
            PG8_LDB(B0, 0, 0); PG8_SCHED; PG8_LDA(At, 0, 0); PG8_STAGE(PG8_SA(1, 1), a1, vAc[1]);
            PG8_WAIT_L(8); PG8_BAR; PG8_WAIT_L(0); PG8_MMA(0, 0, At, B0); PG8_BAR; PG8_SCHED;
            PG8_LDB(B1, 0, 1); PG8_STAGE(PG8_SB(0, 0), b2, voffB);
            PG8_BAR; PG8_WAIT_L(0); PG8_MMA(0, 1, At, B1); PG8_BAR;
            PG8_LDA(At, 0, 1); PG8_STAGE(PG8_SA(0, 0), a2, vAl[0]);
            PG8_BAR; PG8_WAIT_L(0); PG8_MMA(1, 0, At, B0); PG8_BAR; PG8_SCHED;
            PG8_STAGE(PG8_SB(0, 1), b2 + hstep, voffB);
            PG8_WAIT_V(6); PG8_BAR; PG8_MMA(1, 1, At, B1); PG8_BAR;
            PG8_LDB(B0, 1, 0); PG8_SCHED; PG8_LDA(At, 1, 0); PG8_STAGE(PG8_SA(0, 1), a2, vAl[1]);
            PG8_WAIT_L(8); PG8_BAR; PG8_WAIT_L(0); PG8_MMA(0, 0, At, B0); PG8_BAR; PG8_SCHED;
            PG8_LDB(B1, 1, 1); PG8_STAGE(PG8_SB(1, 0), b3, voffB);
            PG8_BAR; PG8_WAIT_L(0); PG8_MMA(0, 1, At, B1); PG8_BAR;
            PG8_LDA(At, 1, 1); PG8_STAGE(PG8_SA(1, 0), a3, vAl[0]);
            PG8_BAR; PG8_WAIT_L(0); PG8_MMA(1, 0, At, B0); PG8_BAR; PG8_SCHED;
            PG8_STAGE(PG8_SB(1, 1), b3 + hstep, voffB);
            PG8_WAIT_V(6); PG8_BAR; PG8_MMA(1, 1, At, B1); PG8_BAR;
            }
        }
        }
        if constexpr (ALIGN_EPI) { if (wr == 0) PG8_BAR; }
        if constexpr (!Epi::AFTER_DRAIN) { E(acc, cur, wr, wc, fr, fq); S.done(cur); }
        if (!has_next) break;
#pragma unroll
        for (int a = 0; a < 2; ++a)
#pragma unroll
            for (int b = 0; b < 2; ++b)
#pragma unroll
                for (int m = 0; m < 4; ++m)
#pragma unroll
                    for (int n = 0; n < 2; ++n) acc[a][b][m][n] = (f32x4){0.f, 0.f, 0.f, 0.f};
        cur = nxt; cA = nA; cB = nB; ++ui;
        if constexpr (GATHER) { _Pragma("unroll") for (int _h = 0; _h < 2; ++_h) _Pragma("unroll") for (int _i = 0; _i < 2; ++_i) vAc[_h][_i] = vAn[_h][_i]; }
        if constexpr (ALIGN_EPI) { if (wr == 1) PG8_BAR; }
    }
    PG8_WAIT_V(0);
    if constexpr (!ALIGN_EPI) { if (wr == 0) PG8_BAR; }
    PG8_BAR;
    if constexpr (Epi::AFTER_DRAIN) { E.fused(acc, cur, wr, wc, fr, fq, lds, wid, lane); S.done(cur); }
#undef PG8_SA
#undef PG8_SB
#undef PG8_STAGE
#undef PG8_GVOFF
#undef PG8_LDA
#undef PG8_LDB
#undef PG8_MMA
#undef PG8_WAIT_V
#undef PG8_WAIT_L
#undef PG8_BAR
#undef PG8_SCHED
}
}

namespace attn {
constexpr int D = 128, NW = 8, QBLK = 32, KVBLK = 64;
constexpr float SCALE = 0.088388347648318440f;
constexpr float THR = 8.f;
constexpr int LDQ = 1024, LDK = 256, LDO = 1536;
constexpr size_t SHM_V = KVBLK * D * 2, SHM_K = KVBLK * D * 2, SHM_ATTN = 3 * SHM_V + 3 * SHM_K + NW * 64 * 4;
typedef unsigned short bf16;
using bf16x8 = __attribute__((ext_vector_type(8))) short;
using s16x4  = __attribute__((ext_vector_type(4))) short;
using f32x16 = __attribute__((ext_vector_type(16))) float;
using u32x4  = __attribute__((ext_vector_type(4))) unsigned;
#define KSWZ(row, colB) ((row) * 256 + ((colB) ^ (((row) & 7) << 4)))
#define SBAR() __builtin_amdgcn_sched_barrier(0)
__device__ __forceinline__ int crow(int r, int hi) { return (r & 3) + 8 * (r >> 2) + 4 * hi; }
__device__ __forceinline__ unsigned cvtpk(float lo, float hi) { unsigned r; asm volatile("v_cvt_pk_bf16_f32 %0, %1, %2" : "=v"(r) : "v"(lo), "v"(hi)); return r; }
constexpr float THR2 = THR * 1.4426950408889634f;
__device__ __forceinline__ float bf16r(float x) { const unsigned u = __float_as_uint(x); return __uint_as_float((u + 0x7fffu + ((u >> 16) & 1u)) & 0xffff0000u); }
__device__ __forceinline__ void partialSM(f32x16& p0, f32x16& p1, float& mb, bool first, float& alpha, f32x16* o, float* al_l, int r32, int hi) {
  float pmax = p0[0]; for (int r = 1; r < 16; ++r) pmax = fmaxf(pmax, p0[r]); for (int r = 0; r < 16; ++r) pmax = fmaxf(pmax, p1[r]);
  { auto rr = __builtin_amdgcn_permlane32_swap(__float_as_uint(pmax), __float_as_uint(pmax), false, false);
    pmax = fmaxf(__uint_as_float(rr[0]), __uint_as_float(rr[1])); }
  if (__builtin_expect(!first && __all(pmax <= THR2), 1)) { alpha = 1.f; }
  else { const float mbn = bf16r(mb + (first ? pmax : fmaxf(pmax, 0.f))), dl = mbn - mb; alpha = first ? 1.f : __builtin_amdgcn_exp2f(-dl); mb = mbn;
    for (int r = 0; r < 16; ++r) p0[r] -= dl; for (int r = 0; r < 16; ++r) p1[r] -= dl;
    if (!first) {
      if (hi == 0) al_l[r32] = alpha; asm volatile("s_waitcnt lgkmcnt(0)" ::: "memory");
      for (int d = 0; d < 4; ++d) for (int r = 0; r < 16; ++r) o[d][r] *= al_l[crow(r, hi)]; } }
  for (int r = 0; r < 16; ++r) p0[r] = __builtin_amdgcn_exp2f(p0[r]);
}
__device__ __forceinline__ void finishSM(f32x16& p0, f32x16& p1, float alpha, float& l_reg, bf16x8& pa0, bf16x8& pa1, bf16x8& pa2, bf16x8& pa3) {
  for (int r = 0; r < 16; ++r) p1[r] = __builtin_amdgcn_exp2f(p1[r]);
  float ps = 0; for (int r = 0; r < 16; ++r) ps += p0[r]; for (int r = 0; r < 16; ++r) ps += p1[r];
  { auto rr = __builtin_amdgcn_permlane32_swap(__float_as_uint(ps), __float_as_uint(ps), false, false);
    ps = __uint_as_float(rr[0]) + __uint_as_float(rr[1]); }
  l_reg = l_reg * alpha + ps;
#define PK4(P, BASE, OUT) do { unsigned a0 = cvtpk(P[BASE + 0], P[BASE + 1]), a1 = cvtpk(P[BASE + 2], P[BASE + 3]);   \
    unsigned b0 = cvtpk(P[BASE + 4], P[BASE + 5]), b1 = cvtpk(P[BASE + 6], P[BASE + 7]);                              \
    auto r0 = __builtin_amdgcn_permlane32_swap(a0, b0, false, false); auto r1 = __builtin_amdgcn_permlane32_swap(a1, b1, false, false); \
    u32x4 w = {r0[0], r1[0], r0[1], r1[1]}; OUT = *reinterpret_cast<bf16x8*>(&w); } while (0)
  PK4(p0, 0, pa0); PK4(p0, 8, pa1); PK4(p1, 0, pa2); PK4(p1, 8, pa3);
#undef PK4
}
__device__ __forceinline__ void qkt(f32x16& p0, f32x16& p1, const bf16* Ks, const bf16x8* qr, int r32, int hi) {
  p0 = f32x16{}; p1 = f32x16{};
  for (int d0 = 0; d0 < 8; ++d0) { int cb = (d0 * 16 + hi * 8) * 2;
    bf16x8 b0 = *reinterpret_cast<const bf16x8*>((const char*)Ks + KSWZ(r32, cb));
    bf16x8 b1 = *reinterpret_cast<const bf16x8*>((const char*)Ks + KSWZ(32 + r32, cb));
    p0 = __builtin_amdgcn_mfma_f32_32x32x16_bf16(b0, qr[d0], p0, 0, 0, 0);
    p1 = __builtin_amdgcn_mfma_f32_32x32x16_bf16(b1, qr[d0], p1, 0, 0, 0); }
}
__device__ __forceinline__ int v_st(int k, int c) { const int kk = (k & ~0xC) | ((k & 4) << 1) | ((k & 8) >> 1); return ((kk >> 3) * 4 + (c >> 5)) * 512 + ((kk & 7) * 32 + (c & 31)) * 2; }
__device__ __forceinline__ int v_rd_base(int lane) { return ((lane & 3) << 3) | (((lane >> 2) & 3) << 6) | (((lane >> 4) & 1) << 5) | (((lane >> 5) & 1) << 8); }
constexpr int v_rd_off(int d0, int ks, int half) { return d0 * 512 + ks * 4096 + half * 2048; }
template <int OFF> __device__ __forceinline__ s16x4 tr_read(int vb) {
  s16x4 r; asm volatile("ds_read_b64_tr_b16 %0, %1 offset:%2" : "=&v"(r) : "v"(vb), "i"(OFF) : "memory"); return r;
}
template <int D0> __device__ __forceinline__ void pv_one(f32x16& od, int vb, bf16x8 pa0, bf16x8 pa1, bf16x8 pa2, bf16x8 pa3) {
  const s16x4 l0 = tr_read<v_rd_off(D0, 0, 0)>(vb), h0 = tr_read<v_rd_off(D0, 0, 1)>(vb), l1 = tr_read<v_rd_off(D0, 1, 0)>(vb), h1 = tr_read<v_rd_off(D0, 1, 1)>(vb);
  const s16x4 l2 = tr_read<v_rd_off(D0, 2, 0)>(vb), h2 = tr_read<v_rd_off(D0, 2, 1)>(vb), l3 = tr_read<v_rd_off(D0, 3, 0)>(vb), h3 = tr_read<v_rd_off(D0, 3, 1)>(vb);
  asm volatile("s_waitcnt lgkmcnt(0)" ::: "memory"); SBAR();
#define PK(L, H) (bf16x8){L[0], L[1], L[2], L[3], H[0], H[1], H[2], H[3]}
  od = __builtin_amdgcn_mfma_f32_32x32x16_bf16(pa0, PK(l0, h0), od, 0, 0, 0);
  od = __builtin_amdgcn_mfma_f32_32x32x16_bf16(pa1, PK(l1, h1), od, 0, 0, 0);
  od = __builtin_amdgcn_mfma_f32_32x32x16_bf16(pa2, PK(l2, h2), od, 0, 0, 0);
  od = __builtin_amdgcn_mfma_f32_32x32x16_bf16(pa3, PK(l3, h3), od, 0, 0, 0);
#undef PK
}
__device__ __forceinline__ void pv_d0(f32x16* o, int vb, bf16x8 pa0, bf16x8 pa1, bf16x8 pa2, bf16x8 pa3) {
  pv_one<0>(o[0], vb, pa0, pa1, pa2, pa3); pv_one<1>(o[1], vb, pa0, pa1, pa2, pa3); pv_one<2>(o[2], vb, pa0, pa1, pa2, pa3); pv_one<3>(o[3], vb, pa0, pa1, pa2, pa3);
}
__device__ __forceinline__ void mstage(f32x16* o, f32x16& p0, f32x16& p1, int vb, int kb0, int kb1, int kb2, int kb3, const bf16x8* qr, bf16x8 pa0, bf16x8 pa1, bf16x8 pa2, bf16x8 pa3, bf16x8 kx, bf16x8 qx) {
  asm volatile(
    "s_nop 4\n\t"
    "ds_read_b128 v[200:203], %[kb0] offset:0\n\t"
    "ds_read_b128 v[204:207], %[kb0] offset:8192\n\t"
    "ds_read_b64_tr_b16 v[208:209], %[vb] offset:0\n\t"
    "ds_read_b64_tr_b16 v[210:211], %[vb] offset:2048\n\t"
    "ds_read_b64_tr_b16 v[212:213], %[vb] offset:4096\n\t"
    "ds_read_b64_tr_b16 v[214:215], %[vb] offset:6144\n\t"
    "ds_read_b128 v[216:219], %[kb1] offset:0\n\t"
    "ds_read_b128 v[220:223], %[kb1] offset:8192\n\t"
    "v_mfma_f32_32x32x16_bf16 %[p0], %[kx], %[qx], 0\n\t"
    "v_mfma_f32_32x32x16_bf16 %[p1], %[kx], %[qx], 0\n\t"
    "s_waitcnt lgkmcnt(6)\n\t"
    "v_mfma_f32_32x32x16_bf16 %[p0], v[200:203], %[q0], %[p0]\n\t"
    "v_mfma_f32_32x32x16_bf16 %[p1], v[204:207], %[q0], %[p1]\n\t"
    "ds_read_b64_tr_b16 v[200:201], %[vb] offset:8192\n\t"
    "ds_read_b64_tr_b16 v[202:203], %[vb] offset:10240\n\t"
    "ds_read_b64_tr_b16 v[204:205], %[vb] offset:12288\n\t"
    "ds_read_b64_tr_b16 v[206:207], %[vb] offset:14336\n\t"
    "s_waitcnt lgkmcnt(6)\n\t"
    "v_mfma_f32_32x32x16_bf16 %[o0], %[a0], v[208:211], %[o0]\n\t"
    "v_mfma_f32_32x32x16_bf16 %[o0], %[a1], v[212:215], %[o0]\n\t"
    "ds_read_b128 v[208:211], %[kb2] offset:0\n\t"
    "ds_read_b128 v[212:215], %[kb2] offset:8192\n\t"
    "s_waitcnt lgkmcnt(6)\n\t"
    "v_mfma_f32_32x32x16_bf16 %[p0], v[216:219], %[q1], %[p0]\n\t"
    "v_mfma_f32_32x32x16_bf16 %[p1], v[220:223], %[q1], %[p1]\n\t"
    "ds_read_b64_tr_b16 v[216:217], %[vb] offset:512\n\t"
    "ds_read_b64_tr_b16 v[218:219], %[vb] offset:2560\n\t"
    "ds_read_b64_tr_b16 v[220:221], %[vb] offset:4608\n\t"
    "ds_read_b64_tr_b16 v[222:223], %[vb] offset:6656\n\t"
    "s_waitcnt lgkmcnt(6)\n\t"
    "v_mfma_f32_32x32x16_bf16 %[o0], %[a2], v[200:203], %[o0]\n\t"
    "v_mfma_f32_32x32x16_bf16 %[o0], %[a3], v[204:207], %[o0]\n\t"
    "ds_read_b128 v[200:203], %[kb3] offset:0\n\t"
    "ds_read_b128 v[204:207], %[kb3] offset:8192\n\t"
    "s_waitcnt lgkmcnt(6)\n\t"
    "v_mfma_f32_32x32x16_bf16 %[p0], v[208:211], %[q2], %[p0]\n\t"
    "v_mfma_f32_32x32x16_bf16 %[p1], v[212:215], %[q2], %[p1]\n\t"
    "ds_read_b64_tr_b16 v[208:209], %[vb] offset:8704\n\t"
    "ds_read_b64_tr_b16 v[210:211], %[vb] offset:10752\n\t"
    "ds_read_b64_tr_b16 v[212:213], %[vb] offset:12800\n\t"
    "ds_read_b64_tr_b16 v[214:215], %[vb] offset:14848\n\t"
    "s_waitcnt lgkmcnt(6)\n\t"
    "v_mfma_f32_32x32x16_bf16 %[o1], %[a0], v[216:219], %[o1]\n\t"
    "v_mfma_f32_32x32x16_bf16 %[o1], %[a1], v[220:223], %[o1]\n\t"
    "ds_read_b128 v[216:219], %[kb0] offset:128\n\t"
    "ds_read_b128 v[220:223], %[kb0] offset:8320\n\t"
    "s_waitcnt lgkmcnt(6)\n\t"
    "v_mfma_f32_32x32x16_bf16 %[p0], v[200:203], %[q3], %[p0]\n\t"
    "v_mfma_f32_32x32x16_bf16 %[p1], v[204:207], %[q3], %[p1]\n\t"
    "ds_read_b64_tr_b16 v[200:201], %[vb] offset:1024\n\t"
    "ds_read_b64_tr_b16 v[202:203], %[vb] offset:3072\n\t"
    "ds_read_b64_tr_b16 v[204:205], %[vb] offset:5120\n\t"
    "ds_read_b64_tr_b16 v[206:207], %[vb] offset:7168\n\t"
    "s_waitcnt lgkmcnt(6)\n\t"
    "v_mfma_f32_32x32x16_bf16 %[o1], %[a2], v[208:211], %[o1]\n\t"
    "v_mfma_f32_32x32x16_bf16 %[o1], %[a3], v[212:215], %[o1]\n\t"
    "ds_read_b128 v[208:211], %[kb1] offset:128\n\t"
    "ds_read_b128 v[212:215], %[kb1] offset:8320\n\t"
    "s_waitcnt lgkmcnt(6)\n\t"
    "v_mfma_f32_32x32x16_bf16 %[p0], v[216:219], %[q4], %[p0]\n\t"
    "v_mfma_f32_32x32x16_bf16 %[p1], v[220:223], %[q4], %[p1]\n\t"
    "ds_read_b64_tr_b16 v[216:217], %[vb] offset:9216\n\t"
    "ds_read_b64_tr_b16 v[218:219], %[vb] offset:11264\n\t"
    "ds_read_b64_tr_b16 v[220:221], %[vb] offset:13312\n\t"
    "ds_read_b64_tr_b16 v[222:223], %[vb] offset:15360\n\t"
    "s_waitcnt lgkmcnt(6)\n\t"
    "v_mfma_f32_32x32x16_bf16 %[o2], %[a0], v[200:203], %[o2]\n\t"
    "v_mfma_f32_32x32x16_bf16 %[o2], %[a1], v[204:207], %[o2]\n\t"
    "ds_read_b128 v[200:203], %[kb2] offset:128\n\t"
    "ds_read_b128 v[204:207], %[kb2] offset:8320\n\t"
    "s_waitcnt lgkmcnt(6)\n\t"
    "v_mfma_f32_32x32x16_bf16 %[p0], v[208:211], %[q5], %[p0]\n\t"
    "v_mfma_f32_32x32x16_bf16 %[p1], v[212:215], %[q5], %[p1]\n\t"
    "ds_read_b64_tr_b16 v[208:209], %[vb] offset:1536\n\t"
    "ds_read_b64_tr_b16 v[210:211], %[vb] offset:3584\n\t"
    "ds_read_b64_tr_b16 v[212:213], %[vb] offset:5632\n\t"
    "ds_read_b64_tr_b16 v[214:215], %[vb] offset:7680\n\t"
    "s_waitcnt lgkmcnt(6)\n\t"
    "v_mfma_f32_32x32x16_bf16 %[o2], %[a2], v[216:219], %[o2]\n\t"
    "v_mfma_f32_32x32x16_bf16 %[o2], %[a3], v[220:223], %[o2]\n\t"
    "ds_read_b128 v[216:219], %[kb3] offset:128\n\t"
    "ds_read_b128 v[220:223], %[kb3] offset:8320\n\t"
    "s_waitcnt lgkmcnt(6)\n\t"
    "v_mfma_f32_32x32x16_bf16 %[p0], v[200:203], %[q6], %[p0]\n\t"
    "v_mfma_f32_32x32x16_bf16 %[p1], v[204:207], %[q6], %[p1]\n\t"
    "ds_read_b64_tr_b16 v[200:201], %[vb] offset:9728\n\t"
    "ds_read_b64_tr_b16 v[202:203], %[vb] offset:11776\n\t"
    "ds_read_b64_tr_b16 v[204:205], %[vb] offset:13824\n\t"
    "ds_read_b64_tr_b16 v[206:207], %[vb] offset:15872\n\t"
    "s_waitcnt lgkmcnt(6)\n\t"
    "v_mfma_f32_32x32x16_bf16 %[o3], %[a0], v[208:211], %[o3]\n\t"
    "v_mfma_f32_32x32x16_bf16 %[o3], %[a1], v[212:215], %[o3]\n\t"
    "s_waitcnt lgkmcnt(4)\n\t"
    "v_mfma_f32_32x32x16_bf16 %[p0], v[216:219], %[q7], %[p0]\n\t"
    "v_mfma_f32_32x32x16_bf16 %[p1], v[220:223], %[q7], %[p1]\n\t"
    "s_waitcnt lgkmcnt(0)\n\t"
    "v_mfma_f32_32x32x16_bf16 %[o3], %[a2], v[200:203], %[o3]\n\t"
    "v_mfma_f32_32x32x16_bf16 %[o3], %[a3], v[204:207], %[o3]\n\t"
    "s_nop 15\n\t"
    "s_nop 7\n\t"
    : [o0] "+v"(o[0]), [o1] "+v"(o[1]), [o2] "+v"(o[2]), [o3] "+v"(o[3]), [p0] "=&v"(p0), [p1] "=&v"(p1)
    : [q0] "v"(qr[0]), [q1] "v"(qr[1]), [q2] "v"(qr[2]), [q3] "v"(qr[3]), [q4] "v"(qr[4]), [q5] "v"(qr[5]), [q6] "v"(qr[6]), [q7] "v"(qr[7]),
      [a0] "v"(pa0), [a1] "v"(pa1), [a2] "v"(pa2), [a3] "v"(pa3), [vb] "v"(vb), [kb0] "v"(kb0), [kb1] "v"(kb1), [kb2] "v"(kb2), [kb3] "v"(kb3), [kx] "v"(kx), [qx] "v"(qx)
    : "memory", "v200", "v201", "v202", "v203", "v204", "v205", "v206", "v207", "v208", "v209", "v210", "v211", "v212", "v213", "v214", "v215", "v216", "v217", "v218", "v219", "v220", "v221", "v222", "v223");
}
__device__ __forceinline__ void attn_dense_body(const bf16* __restrict__ Qb, bf16* __restrict__ Ob, const bf16* __restrict__ Kh, const bf16* __restrict__ Vh, int seq, char* lds,
                                                const float* __restrict__ qnw, const float2* __restrict__ rope, int pos0, int wave_s) {
  int tid; asm volatile("v_mbcnt_lo_u32_b32 %0, -1, 0\n\tv_mbcnt_hi_u32_b32 %0, -1, %0\n\tv_lshl_or_b32 %0, %1, 6, %0" : "=&v"(tid) : "s"(wave_s));
  const int wid = tid >> 6, lane = tid & 63, r32 = lane & 31, hi = lane >> 5, wu = __builtin_amdgcn_readfirstlane(tid >> 6);
  bf16* V_lds = (bf16*)lds; bf16* K_lds = (bf16*)(lds + 3 * SHM_V);
  float* ws = (float*)(lds + 3 * SHM_V + 3 * SHM_K) + wu * 64; float* li_l = ws; float* al_l = ws + 32;
  float mb = 0.f, l_reg = 0; f32x16 o[4] = {}; bf16x8 qr[8];
  const bf16* Qw = Qb + (long)(wu * QBLK + r32) * LDQ + hi * 8;
  {
    u32x4 raw[8]; float ss = 0.f;
#pragma unroll
    for (int d0 = 0; d0 < 8; ++d0) { raw[d0] = *reinterpret_cast<const u32x4*>(Qw + d0 * 16);
#pragma unroll
      for (int i = 0; i < 4; ++i) { const float a = __uint_as_float(raw[d0][i] << 16), b = __uint_as_float(raw[d0][i] & 0xffff0000u); ss += a * a + b * b; } }
    { auto rr = __builtin_amdgcn_permlane32_swap(__float_as_uint(ss), __float_as_uint(ss), false, false); ss = __uint_as_float(rr[0]) + __uint_as_float(rr[1]); }
    const float rstd = rsqrtf(ss * (1.f / 128.f) + 1e-6f) * (SCALE * 1.4426950408889634f);
    const int pos = pos0 + wu * QBLK + r32;
#pragma unroll
    for (int d0 = 0; d0 < 4; ++d0) {
      float fa[8], fb[8];
      const float* wa = qnw + d0 * 16 + hi * 8; const float* wb = wa + 64;
#pragma unroll
      for (int i = 0; i < 4; ++i) { fa[2 * i] = __uint_as_float(raw[d0][i] << 16) * rstd * wa[2 * i]; fa[2 * i + 1] = __uint_as_float(raw[d0][i] & 0xffff0000u) * rstd * wa[2 * i + 1];
        fb[2 * i] = __uint_as_float(raw[d0 + 4][i] << 16) * rstd * wb[2 * i]; fb[2 * i + 1] = __uint_as_float(raw[d0 + 4][i] & 0xffff0000u) * rstd * wb[2 * i + 1]; }
      if (rope) { const int j0 = d0 * 16 + hi * 8;
        const float2* tp = (d0 < 2) ? rope + (pos >> 6) * 32 + j0 : rope + (pos & 63) * 32 + (j0 - 32);
#pragma unroll
        for (int i = 0; i < 8; ++i) { const float2 cs = tp[i]; const float a = fa[i], b = fb[i]; fa[i] = a * cs.x - b * cs.y; fb[i] = a * cs.y + b * cs.x; } }
      { u32x4 w = {cvtpk(fa[0], fa[1]), cvtpk(fa[2], fa[3]), cvtpk(fa[4], fa[5]), cvtpk(fa[6], fa[7])}; qr[d0] = *reinterpret_cast<bf16x8*>(&w); }
      { u32x4 w = {cvtpk(fb[0], fb[1]), cvtpk(fb[2], fb[3]), cvtpk(fb[4], fb[5]), cvtpk(fb[6], fb[7])}; qr[d0 + 4] = *reinterpret_cast<bf16x8*>(&w); }
    }
  }
  const int vb0 = (int)(uintptr_t)V_lds + v_rd_base(lane);
  unsigned koff, voff;
  { const int krow = 4 * wu + (lane >> 4); koff = (unsigned)(krow * (LDK * 2) + (((lane & 15) ^ (krow & 7)) << 4));
    const int blk = 2 * wu + (lane >> 5), kk = (blk >> 2) * 8 + ((lane & 31) >> 2), kx = (kk & ~0xC) | ((kk & 4) << 1) | ((kk & 8) >> 1), cc = (blk & 3) * 32 + (lane & 3) * 8;
    voff = (unsigned)(kx * (LDK * 2) + cc * 2); }
  typedef __attribute__((address_space(3))) unsigned lds_u32;
#define DMA2(gbase, off, ldsbase) do { const char* g_ = (const char*)(gbase) + (off); \
    __builtin_amdgcn_global_load_lds((const unsigned*)g_, (lds_u32*)(unsigned)(uintptr_t)((ldsbase) + wu * 1024), 16, 0, 0); \
    __builtin_amdgcn_global_load_lds((const unsigned*)(g_ + 32 * LDK * 2), (lds_u32*)(unsigned)(uintptr_t)((ldsbase) + 8192 + wu * 1024), 16, 0, 0); } while (0)
#define LOADK(t, b) DMA2((const char*)Kh + (long)(t) * (KVBLK * LDK * 2), koff, (char*)K_lds + (b) * SHM_K)
#define LOADV(t, b) DMA2((const char*)Vh + (long)(t) * (KVBLK * LDK * 2), voff, (char*)V_lds + (b) * SHM_V)
#define VMWAIT() asm volatile("s_waitcnt vmcnt(0)" ::: "memory")
#define WGBAR() asm volatile("s_waitcnt lgkmcnt(0)\n\ts_barrier" ::: "memory")
#define SOFTMAX_(first) do { float al_; partialSM(p0, p1, mb, first, al_, o, al_l, r32, hi); finishSM(p0, p1, al_, l_reg, pa0, pa1, pa2, pa3); } while (0)
#define SOFTMAX() do { __builtin_amdgcn_s_setprio(1); SOFTMAX_(false); __builtin_amdgcn_s_setprio(0); } while (0)
#define QX() ({ u32x4 w_ = {hi == 0 ? (__float_as_uint(mb) >> 16) : 0u, 0u, 0u, 0u}; *reinterpret_cast<bf16x8*>(&w_); })
#define VMWAIT4() asm volatile("s_waitcnt vmcnt(4)" ::: "memory")
#define STAGE(k, s0, s2) do { LOADK(min((k) + 3, NT - 1), s0); LOADV(min((k) + 2, NT - 1), s2); } while (0)
  int mvb, mk0, mk1, mk2, mk3; bf16x8 mqx;
#define MPREP(sv, sk) do { const int ko_ = (int)((sk) * SHM_K); mvb = vb0 + (int)((sv) * SHM_V); mk0 = kbase + ko_; mk1 = (kbase ^ 32) + ko_; mk2 = (kbase ^ 64) + ko_; mk3 = (kbase ^ 96) + ko_; mqx = QX(); \
    asm volatile("" : "+v"(mvb), "+v"(mk0), "+v"(mk1), "+v"(mk2), "+v"(mk3), "+v"(mqx)); } while (0)
#define MSTAGE() mstage(o, p0, p1, mvb, mk0, mk1, mk2, mk3, qr, pa0, pa1, pa2, pa3, kx, mqx)
#define MLAST() pv_d0(o, mvb, pa0, pa1, pa2, pa3)
  f32x16 p0, p1; bf16x8 pa0, pa1, pa2, pa3; const int NT = seq / KVBLK;
  const int kbase = (int)(uintptr_t)K_lds + KSWZ(r32, hi * 16);
  LOADK(0, 0); LOADV(0, 0); LOADK(1, 1); LOADV(min(1, NT - 1), 1); LOADK(min(2, NT - 1), 2); VMWAIT(); WGBAR();
  qkt(p0, p1, K_lds, qr, r32, hi); SOFTMAX_(true);
  bf16x8 kx; { u32x4 w_ = {hi == 0 ? 0x0000BF80u : 0u, 0u, 0u, 0u}; kx = *reinterpret_cast<bf16x8*>(&w_); }
  MPREP(0, 1); WGBAR();
  if (wid < 4) {
    int s0 = 0, s1 = 1, s2 = 2;
#pragma unroll 1
    for (int k = 0; k < NT - 1; ++k) {
      MSTAGE(); WGBAR();
      __builtin_amdgcn_s_setprio(1); STAGE(k, s0, s2); SOFTMAX_(false);
      { const int t_ = s0; s0 = s1; s1 = s2; s2 = t_; }
      MPREP(s0, s1); __builtin_amdgcn_s_setprio(0);
      VMWAIT4(); WGBAR();
    }
    MLAST(); WGBAR();
    WGBAR();
  } else {
    int s0 = 0, s1 = 1, s2 = 2;
    STAGE(0, s0, s2); WGBAR();
#pragma unroll 1
    for (int k = 0; k < NT - 1; ++k) {
      MSTAGE(); VMWAIT4(); WGBAR();
      { const int t_ = s0; s0 = s1; s1 = s2; s2 = t_; }
      __builtin_amdgcn_s_setprio(1); if (k + 1 < NT - 1) STAGE(k + 1, s0, s2);
      SOFTMAX_(false); MPREP(s0, s1); __builtin_amdgcn_s_setprio(0);
      WGBAR();
    }
    MLAST(); WGBAR();
  }
  VMWAIT();
  if (hi == 0) li_l[r32] = l_reg; asm volatile("s_waitcnt lgkmcnt(0)" ::: "memory");
  float rli[16];
#pragma unroll
  for (int r = 0; r < 16; ++r) rli[r] = __builtin_amdgcn_rcpf(li_l[crow(r, hi)]);
  bf16* Ow = Ob + (long)(wu * QBLK) * LDO;
#pragma unroll
  for (int r = 0; r < 16; ++r) { int orow = crow(r, hi);
    for (int d0 = 0; d0 < 4; ++d0) Ow[(long)orow * LDO + d0 * 32 + r32] = (bf16)(cvtpk(o[d0][r] * rli[r], 0.f) & 0xffffu); }
  __syncthreads();
#undef LD8
#undef LOADK
#undef LOADV
#undef DMA2
#undef VMWAIT
#undef WGBAR
#undef SOFTMAX
#undef SOFTMAX_
#undef QX
#undef STAGE
#undef VMWAIT4
#undef MSTAGE
#undef MLAST
}
#undef KSWZ
#undef SBAR
}

constexpr int NWAVES = 8, NTHR = 512;
constexpr int NB = 8, SEQ = 4096, DM = 1024, CL = 256, T_LAT = NB * SEQ, T_CTX = NB * CL, R_ALL = T_LAT + T_CTX;
constexpr int SKV = SEQ + CL;
constexpr int NH = 8, NKV = 2, HD = 128;
constexpr int HYW = 512, NE = 64, EDIM = 512;
constexpr int INW = 5120, NA_COLS = 3584, NU_COLS = 1536;
constexpr int NSLOT_MAX = 86016;
constexpr float EPS = 1e-6f;
enum { I_X = 0, I_C, I_CTX, I_CCTX, I_WADA, I_BADA, I_N1W, I_N2W, I_WIN, I_QNW, I_KNW, I_HCW, I_HCB, I_PW1, I_PB1, I_PF1, I_PW2, I_PB2, I_PF2, I_PW3, I_SKIP,
       I_WAP, I_WHP, I_WOUT, I_RW, I_RB, I_EW1, I_EW3, I_EW2, I_FNW, N_IN };
constexpr size_t MiB = 1u << 20;
constexpr size_t WS_CTL = 0, CTL_ZERO_BYTES = 1 * MiB;
constexpr size_t WS_MODP = 1 * MiB;
constexpr size_t WS_MODS = 8 * MiB;
constexpr size_t WS_ROPE = WS_MODS + 512 * 1024;
constexpr size_t WS_H2 = 9 * MiB;
constexpr size_t WS_HIST = 12 * MiB;
constexpr size_t WS_TOKE = WS_HIST + 65536;
constexpr size_t WS_TOKG = WS_TOKE + (size_t)R_ALL * 8;
constexpr size_t WS_TOKR = WS_TOKG + (size_t)R_ALL * 8;
constexpr size_t WS_TOKS = WS_TOKR + (size_t)R_ALL * 8;
constexpr size_t WS_BLKE = WS_TOKS + (size_t)R_ALL * 8;
static_assert(WS_BLKE + 4096 <= 14 * MiB, "misc region");
constexpr size_t WS_STOK = 14 * MiB;
static_assert(WS_STOK + (size_t)86016 * 4 <= 16 * MiB, "misc region 2");
constexpr size_t WS_WSM = 16 * MiB;
constexpr size_t WSM_LAYER = 15 * MiB, WSM_WINA = 0, WSM_WINU = 7 * MiB, WSM_WAP = 10 * MiB, WSM_WHP = 12 * MiB, WSM_WOUT = 13 * MiB;
constexpr size_t WS_BTR = WS_WSM + 2 * WSM_LAYER;
constexpr size_t WS_X = 48 * MiB;
constexpr size_t WS_KSPEC = 184 * MiB;
constexpr size_t WS_W13 = 248 * MiB;
constexpr size_t WS_W2T = 376 * MiB;
constexpr size_t WS_OV = 440 * MiB;
constexpr size_t WS_HX = WS_OV, WS_MG = WS_OV;
constexpr size_t WS_Q = WS_OV + 68 * MiB;
constexpr size_t WS_KB = 150 * MiB, WS_VB = 167 * MiB;
constexpr size_t WS_OY = WS_OV + 136 * MiB;
constexpr size_t WS_YHT = 116 * MiB;
constexpr size_t WS_UT = WS_OV + 238 * MiB;
constexpr size_t WS_G = WS_OV + 340 * MiB;
constexpr size_t WS_Y = WS_OV + 68 * MiB;
constexpr size_t WS_HXS = WS_OV + 236 * MiB;
constexpr size_t WS_HMID = WS_OV + 389 * MiB;
constexpr size_t WS_LOG = WS_OV + 372 * MiB;
constexpr size_t WS_FT = WS_OV + 476 * MiB;
constexpr size_t WS_W3S = WS_FT + 64 * MiB;
constexpr size_t WS_H2S = WS_W3S + 2 * MiB;
constexpr size_t WS_END = WS_H2S + 4 * MiB;
static_assert((size_t)R_ALL * 1024 * 2 <= 68 * MiB && (size_t)NB * SKV * 256 * 2 <= 17 * MiB && (size_t)R_ALL * 1536 * 2 <= 102 * MiB && WS_X + (size_t)R_ALL * 1024 * 2 <= WS_YHT && WS_YHT + 34 * MiB <= WS_KB && WS_VB + 17 * MiB <= WS_KSPEC && (size_t)1536 * R_ALL * 2 <= 102 * MiB, "sizes");
static_assert(WS_HMID + (size_t)NSLOT_MAX * 512 * 2 <= WS_END && (size_t)NSLOT_MAX * 1024 * 2 <= 168 * MiB && (size_t)R_ALL * 2048 * 2 <= 136 * MiB && (size_t)R_ALL * 128 * 4 <= 17 * MiB && WS_OY + 102 * MiB <= WS_UT, "sizes2");
constexpr int CW_BAR = 4096;
constexpr int RING_BYTES = 139264, MISC_OFF = RING_BYTES + 320, LDS_BYTES = 147456;

#define GAS __attribute__((address_space(1)))
#define LAS __attribute__((address_space(3)))
typedef unsigned short bf16;
typedef unsigned v4u __attribute__((ext_vector_type(4)));
typedef unsigned v2u __attribute__((ext_vector_type(2)));
typedef float f32x4 __attribute__((ext_vector_type(4)));
typedef float f32x2 __attribute__((ext_vector_type(2)));
__device__ __forceinline__ unsigned f2bf(float f) { unsigned u = __builtin_bit_cast(unsigned, f); return (u + 0x7fffu + ((u >> 16) & 1u)) >> 16; }
__device__ __forceinline__ unsigned pk2(float lo, float hi) { return f2bf(lo) | (f2bf(hi) << 16); }
__device__ __forceinline__ float bf2f(unsigned b) { return __uint_as_float(b << 16); }
__device__ __forceinline__ float wave_sum(float v) {
#define WS_SWZ(o) v += __int_as_float(__builtin_amdgcn_ds_swizzle(__float_as_int(v), ((o) << 10) | 0x1f))
    WS_SWZ(1); WS_SWZ(2); WS_SWZ(4); WS_SWZ(8); WS_SWZ(16);
#undef WS_SWZ
    { auto rr = __builtin_amdgcn_permlane32_swap(__float_as_uint(v), __float_as_uint(v), false, false); v = __uint_as_float(rr[0]) + __uint_as_float(rr[1]); }
    return v;
}
#define LDS_WAIT() asm volatile("s_waitcnt lgkmcnt(0)" ::: "memory")
__device__ __forceinline__ void* opaque_uptr(const void* p) {
    unsigned lo = (unsigned)(uintptr_t)p, hi = (unsigned)((uintptr_t)p >> 32);
    asm volatile("" : "+v"(lo), "+v"(hi));
    lo = __builtin_amdgcn_readfirstlane(lo); hi = __builtin_amdgcn_readfirstlane(hi);
    return (void*)(((uintptr_t)hi << 32) | (uintptr_t)lo);
}
constexpr int PTAB_OFF = RING_BYTES + 1024;
struct InTab { LAS const unsigned long long* t;
    __device__ __forceinline__ const float* operator[](int i) const { const unsigned long long v = t[i];
        const unsigned lo = __builtin_amdgcn_readfirstlane((unsigned)v), hi = __builtin_amdgcn_readfirstlane((unsigned)(v >> 32)); return (const float*)(const GAS float*)(((uintptr_t)hi << 32) | (uintptr_t)lo); } };
__device__ __forceinline__ int opaque_u32(int x) { unsigned v = (unsigned)x; asm volatile("" : "+v"(v)); return (int)__builtin_amdgcn_readfirstlane(v); }
#define XB_TMO      128
#define XB_XCNT(j)  (256  + 64 * (j))
#define XB_XSUB(j)  (1280 + 64 * (j))
#define XB_XGEN(j)  (2304 + 64 * (j))
#define XB_TOP      3328
#define XB_TOPGEN   3392
#define XCD_BAR_WORDS 3456
#define XB_SPIN_CAP (1u << 18)

__device__ __forceinline__ unsigned xb_ld(unsigned* p)              { return __hip_atomic_load(p, __ATOMIC_RELAXED, __HIP_MEMORY_SCOPE_AGENT); }
__device__ __forceinline__ unsigned xb_add(unsigned* p, unsigned v) { return __hip_atomic_fetch_add(p, v, __ATOMIC_RELAXED, __HIP_MEMORY_SCOPE_AGENT); }
__device__ __forceinline__ unsigned xb_xcc_id() { return (unsigned)__builtin_amdgcn_s_getreg((3 << 11) | 20) & 0xFu; }
#define XB_SPIN(cond, bar) do { unsigned _sp = 0; while (cond) { __builtin_amdgcn_s_sleep(1); \
    if ((++_sp & 255u) == 0u) { if (xb_ld(&(bar)[XB_TMO])) break; if (_sp > XB_SPIN_CAP) { atomicAdd(&(bar)[XB_TMO], 1u); break; } } } } while (0)

struct XcdBarrier {
    int w;
    unsigned* bar; unsigned x;
    volatile LAS unsigned* st;
};

__device__ __forceinline__ int xb_lane() { int l; asm volatile("v_mbcnt_lo_u32_b32 %0, -1, 0\n\tv_mbcnt_hi_u32_b32 %0, -1, %0" : "=v"(l)); return l; }
__device__ __forceinline__ XcdBarrier xcd_barrier_post(unsigned* bar, volatile LAS unsigned* st, int wave) {
    XcdBarrier b; b.w = wave; b.bar = bar; b.x = xb_xcc_id(); b.st = st;
    if (wave == 0 && xb_lane() == 0) (void)xb_add(&bar[XB_XCNT(b.x)], 1u);
    return b;
}
__device__ __forceinline__ void xcd_barrier_complete(unsigned* bar, unsigned x, unsigned& nloc, unsigned& nx) {
    const unsigned G = gridDim.x * gridDim.y * gridDim.z;
    unsigned sum, cnt, mine, sp = 0u;
    for (;;) {
        sum = 0u; cnt = 0u; mine = 0u;
#pragma unroll
        for (unsigned j = 0; j < 16; ++j) { const unsigned c = xb_ld(&bar[XB_XCNT(j)]); sum += c; cnt += (c > 0u) ? 1u : 0u; mine = (j == x) ? c : mine; }
        if (sum == G) break;
        __builtin_amdgcn_s_sleep(1);
        if ((++sp & 255u) == 0u) { if (xb_ld(&bar[XB_TMO])) break; if (sp > XB_SPIN_CAP) { atomicAdd(&bar[XB_TMO], 1u); break; } }
    }
    nloc = mine > 0u ? mine : 1u; nx = cnt > 0u ? cnt : 1u;
}

__device__ __forceinline__ void xcd_barrier(const XcdBarrier& b) {
    asm volatile("s_waitcnt vmcnt(0)" ::: "memory");
    __syncthreads();
    if (b.w == 0 && xb_lane() == 0) {
        unsigned* bar = b.bar;
        __builtin_amdgcn_s_waitcnt(0);
        unsigned nloc = b.st[0], nx = b.st[1];
        if (nloc == 0u) { xcd_barrier_complete(bar, b.x, nloc, nx); b.st[0] = nloc; b.st[1] = nx; }
        const unsigned old = xb_add(&bar[XB_XSUB(b.x)], 1u);
        const unsigned gen = old / nloc;
        if (old + 1u == (gen + 1u) * nloc) {
            __builtin_amdgcn_fence(__ATOMIC_RELEASE, "agent");
            asm volatile("s_waitcnt vmcnt(0)" ::: "memory");
            const unsigned og = xb_add(&bar[XB_TOP], 1u);
            const unsigned tg = og / nx;
            if (og + 1u == (tg + 1u) * nx) xb_add(&bar[XB_TOPGEN], 1u);
            else XB_SPIN(xb_ld(&bar[XB_TOPGEN]) == tg, bar);
            __builtin_amdgcn_fence(__ATOMIC_ACQUIRE, "agent");
            xb_add(&bar[XB_XGEN(b.x)], 1u);
            asm volatile("s_waitcnt vmcnt(0)" ::: "memory");
        } else {
            XB_SPIN(xb_ld(&bar[XB_XGEN(b.x)]) == gen, bar);
            __builtin_amdgcn_fence(__ATOMIC_ACQUIRE, "agent");
            asm volatile("s_waitcnt vmcnt(0)" ::: "memory");
        }
    }
    __syncthreads();
}

#define HD __device__ __forceinline__
#define FLDS LAS
#define SINCOSPI(x, s, c) sincospif(x, s, c)
#define SHFL_XOR1(x) __int_as_float(__builtin_amdgcn_mov_dpp(__float_as_int(x), 0xB1, 0xf, 0xf, true))
__device__ __forceinline__ f32x2 opaque_f2(f32x2 a) { asm volatile("" : "+v"(a)); return a; }
#define OPAQUE(x) opaque_f2(x)
HD f32x2 cmul(f32x2 a, f32x2 b) { return (f32x2){a.x * b.x - a.y * b.y, a.x * b.y + a.y * b.x}; }
HD f32x2 cmulc(f32x2 a, f32x2 b) { return (f32x2){a.x * b.x + a.y * b.y, a.y * b.x - a.x * b.y}; }
template <int SG> HD f32x2 muli(f32x2 a) { return SG < 0 ? (f32x2){a.y, -a.x} : (f32x2){-a.y, a.x}; }
template <int SG> HD void dft4(f32x2& a0, f32x2& a1, f32x2& a2, f32x2& a3) {
    const f32x2 t0 = a0 + a2, t1 = a0 - a2, t2 = a1 + a3, t3 = muli<SG>(a1 - a3);
    a0 = t0 + t2; a2 = t0 - t2; a1 = t1 + t3; a3 = t1 - t3;
}
template <int SG, int P> HD f32x2 tw16() {
    constexpr float C[16] = {1.f, 0.92387953251128674f, 0.70710678118654752f, 0.38268343236508977f, 0.f, -0.38268343236508977f, -0.70710678118654752f, -0.92387953251128674f,
                             -1.f, -0.92387953251128674f, -0.70710678118654752f, -0.38268343236508977f, 0.f, 0.38268343236508977f, 0.70710678118654752f, 0.92387953251128674f};
    constexpr float S[16] = {0.f, 0.38268343236508977f, 0.70710678118654752f, 0.92387953251128674f, 1.f, 0.92387953251128674f, 0.70710678118654752f, 0.38268343236508977f,
                             0.f, -0.38268343236508977f, -0.70710678118654752f, -0.92387953251128674f, -1.f, -0.92387953251128674f, -0.70710678118654752f, -0.38268343236508977f};
    return (f32x2){C[P & 15], (float)SG * S[P & 15]};
}
template <int SG> HD void dft16(f32x2 (&v)[16]) {
    dft4<SG>(v[0], v[4], v[8], v[12]); dft4<SG>(v[1], v[5], v[9], v[13]); dft4<SG>(v[2], v[6], v[10], v[14]); dft4<SG>(v[3], v[7], v[11], v[15]);
    v[5] = cmul(v[5], tw16<SG, 1>()); v[6] = cmul(v[6], tw16<SG, 2>()); v[7] = cmul(v[7], tw16<SG, 3>());
    v[9] = cmul(v[9], tw16<SG, 2>()); v[10] = muli<SG>(v[10]); v[11] = cmul(v[11], tw16<SG, 6>());
    v[13] = cmul(v[13], tw16<SG, 3>()); v[14] = cmul(v[14], tw16<SG, 6>()); v[15] = cmul(v[15], tw16<SG, 9>());
    dft4<SG>(v[0], v[1], v[2], v[3]); dft4<SG>(v[4], v[5], v[6], v[7]); dft4<SG>(v[8], v[9], v[10], v[11]); dft4<SG>(v[12], v[13], v[14], v[15]);
    f32x2 t;
#define SW(a, b) t = v[a]; v[a] = v[b]; v[b] = t
    SW(1, 4); SW(2, 8); SW(3, 12); SW(6, 9); SW(7, 13); SW(11, 14);
#undef SW
}
#ifndef TIE2
#define TIE2(a, b) asm volatile("" : "+v"(a), "+v"(b))
#endif
struct FftTw { f32x2 wA, wC, wI2b, wI2s, wI1b, wI1s; };
HD f32x2 cispi(float x) { float s, c; SINCOSPI(x, &s, &c); return (f32x2){c, s}; }
HD FftTw fft_tw_init(int tid) {
    FftTw w;
    const int m2 = tid & 31, k1 = tid >> 5, j1 = (tid >> 1) & 15, b = tid & 1;
    w.wA = cispi(-2.f * (float)tid / 8192.f);
    w.wC = cispi(-2.f * (float)m2 / 512.f);
    w.wI2b = cispi(-2.f * (float)((m2 * k1) & 8191) / 8192.f);
    w.wI2s = cispi(-2.f * (float)k1 / 256.f);
    w.wI1b = cispi(-2.f * (float)((b * j1) & 31) / 32.f);
    w.wI1s = cispi(-2.f * (float)j1 / 512.f);
    return w;
}
#define FFT_LDS_ELEMS (256 * 33)
template <int NEXT = 0> HD void fft_fA(int tid, f32x2 (&v)[16], const FftTw& w, FLDS f32x2* L) {
    dft16<-1>(v);
    const f32x2 wA0 = OPAQUE(w.wA); const f32x2 wA = NEXT ? cmul(wA0, (f32x2){0.9999997058628822f, -0.0007669903187427045f}) : wA0; f32x2 p = wA;
    const int q = tid >> 5, col = tid & 31;
    L[(0 * 16 + q) * 33 + col] = v[0];
#pragma unroll
    for (int k1 = 1; k1 < 16; ++k1) { TIE2(p, v[k1]); L[(k1 * 16 + q) * 33 + col] = cmul(v[k1], p); p = cmul(p, wA); }
}
HD void fft_fC1(int tid, const FftTw& w, FLDS f32x2* L) {
    const int k1 = tid >> 5, m2 = tid & 31;
    f32x2 v[16];
#pragma unroll
    for (int m1 = 0; m1 < 16; ++m1) v[m1] = L[(k1 * 16 + m1) * 33 + m2];
    dft16<-1>(v);
    const f32x2 wC = OPAQUE(w.wC); f32x2 p = wC;
    L[(k1 * 16 + 0) * 33 + m2] = v[0];
#pragma unroll
    for (int j1 = 1; j1 < 16; ++j1) { TIE2(p, v[j1]); L[(k1 * 16 + j1) * 33 + m2] = cmul(v[j1], p); p = cmul(p, wC); }
}
HD void fft_fC3(int tid, f32x2 (&v)[16], FLDS f32x2* L) {
    const int row = tid >> 1, b = tid & 1; const float sgn = b ? -1.f : 1.f;
#pragma unroll
    for (int m = 0; m < 16; ++m) {
        const f32x2 lo = L[row * 33 + m], hi = L[row * 33 + m + 16];
        v[m] = lo + sgn * hi;
    }
    if (b) {
#define TW32(M) v[M] = cmul(v[M], (f32x2){C32[M], -S32[M]})
        constexpr float C32[16] = {1.f, 0.98078528040323043f, 0.92387953251128674f, 0.83146961230254524f, 0.70710678118654752f, 0.55557023301960218f, 0.38268343236508977f, 0.19509032201612825f,
                                   0.f, -0.19509032201612825f, -0.38268343236508977f, -0.55557023301960218f, -0.70710678118654752f, -0.83146961230254524f, -0.92387953251128674f, -0.98078528040323043f};
        constexpr float S32[16] = {0.f, 0.19509032201612825f, 0.38268343236508977f, 0.55557023301960218f, 0.70710678118654752f, 0.83146961230254524f, 0.92387953251128674f, 0.98078528040323043f,
                                   1.f, 0.98078528040323043f, 0.92387953251128674f, 0.83146961230254524f, 0.70710678118654752f, 0.55557023301960218f, 0.38268343236508977f, 0.19509032201612825f};
        TW32(1); TW32(2); TW32(3); TW32(4); TW32(5); TW32(6); TW32(7); TW32(8); TW32(9); TW32(10); TW32(11); TW32(12); TW32(13); TW32(14); TW32(15);
#undef TW32
    }
    dft16<-1>(v);
}
HD void fft_iI1(int tid, f32x2 (&v)[16], const FftTw& w, FLDS f32x2* L) {
    const int row = tid >> 1, b = tid & 1; const float sgn = b ? -1.f : 1.f;
    dft16<1>(v);
    if (b) {
        constexpr float C32[16] = {1.f, 0.98078528040323043f, 0.92387953251128674f, 0.83146961230254524f, 0.70710678118654752f, 0.55557023301960218f, 0.38268343236508977f, 0.19509032201612825f,
                                   0.f, -0.19509032201612825f, -0.38268343236508977f, -0.55557023301960218f, -0.70710678118654752f, -0.83146961230254524f, -0.92387953251128674f, -0.98078528040323043f};
        constexpr float S32[16] = {0.f, 0.19509032201612825f, 0.38268343236508977f, 0.55557023301960218f, 0.70710678118654752f, 0.83146961230254524f, 0.92387953251128674f, 0.98078528040323043f,
                                   1.f, 0.98078528040323043f, 0.92387953251128674f, 0.83146961230254524f, 0.70710678118654752f, 0.55557023301960218f, 0.38268343236508977f, 0.19509032201612825f};
#define TW32(M) v[M] = cmul(v[M], (f32x2){C32[M], S32[M]})
        TW32(1); TW32(2); TW32(3); TW32(4); TW32(5); TW32(6); TW32(7); TW32(8); TW32(9); TW32(10); TW32(11); TW32(12); TW32(13); TW32(14); TW32(15);
#undef TW32
    }
    const f32x2 wb_ = OPAQUE(w.wI1b), ws_ = OPAQUE(w.wI1s);
    f32x2 p = (f32x2){wb_.x, -wb_.y};
    const f32x2 st = (f32x2){ws_.x, -ws_.y};
#pragma unroll
    for (int m = 0; m < 16; ++m) {
        f32x2 o; o.x = SHFL_XOR1(v[m].x); o.y = SHFL_XOR1(v[m].y);
        f32x2 r = o + sgn * v[m];
        TIE2(p, r); L[row * 33 + m + 16 * b] = cmul(r, p); p = cmul(p, st);
    }
}
template <bool HI = false> HD void fft_iI2(int tid, const FftTw& w, FLDS f32x2* L) {
    const int k1 = tid >> 5, m2 = tid & 31;
    f32x2 v[16];
#pragma unroll
    for (int j1 = 0; j1 < 16; ++j1) v[j1] = L[(k1 * 16 + j1) * 33 + m2];
    dft16<1>(v);
    const f32x2 wb_ = OPAQUE(w.wI2b), ws0_ = OPAQUE(w.wI2s); const f32x2 ws_ = HI ? cmul(ws0_, (f32x2){0.98078528040323043f, -0.19509032201612825f}) : ws0_;
    f32x2 p = (f32x2){wb_.x, -wb_.y};
    const f32x2 st = (f32x2){ws_.x, -ws_.y};
#pragma unroll
    for (int m1 = 0; m1 < 16; ++m1) { TIE2(p, v[m1]); L[(k1 * 16 + m1) * 33 + m2] = cmul(v[m1], p); p = cmul(p, st); }
}
HD void fft_iI3(int tid, f32x2 (&v)[16], FLDS f32x2* L) {
    const int q = tid >> 5, col = tid & 31;
#pragma unroll
    for (int k1 = 0; k1 < 16; ++k1) v[k1] = L[(k1 * 16 + q) * 33 + col];
    dft16<1>(v);
}
template <bool TRAIL> HD void fft_fwd(int tid, f32x2 (&v)[16], const FftTw& tw, LAS f32x2* Lb) {
    fft_fA(tid, v, tw, Lb); __syncthreads(); fft_fC1(tid, tw, Lb); __syncthreads(); fft_fC3(tid, v, Lb); if (TRAIL) __syncthreads();
}
template <bool TRAIL> HD void fft_inv(int tid, f32x2 (&v)[16], const FftTw& tw, LAS f32x2* Lb) {
    fft_iI1(tid, v, tw, Lb); __syncthreads(); fft_iI2(tid, tw, Lb); __syncthreads(); fft_iI3(tid, v, Lb); if (TRAIL) __syncthreads();
}

__device__ __forceinline__ void tr_item(const float* W, int ldn, int k0, int n0, bf16* WT, int Kd, int drow0, LAS float* scr, int lane) {
    const float* src = W + (size_t)(k0 + (lane >> 5)) * ldn + n0 + (lane & 31) * 2;
    f32x2 r[32];
#pragma unroll
    for (int i = 0; i < 32; ++i) r[i] = *(const f32x2*)(src + (size_t)(2 * i) * ldn);
    LAS float* d = scr + (lane >> 5) * 65 + (lane & 31) * 2;
#pragma unroll
    for (int i = 0; i < 32; ++i) { d[(2 * i) * 65] = r[i].x; d[(2 * i) * 65 + 1] = r[i].y; }
    LDS_WAIT(); asm volatile("" ::: "memory");
    const int c = lane & 7;
#pragma unroll
    for (int j = 0; j < 8; ++j) { const int n = (lane >> 3) + 8 * j; const LAS float* s = scr + (8 * c) * 65 + n;
        v4u o; o.x = pk2(s[0 * 65], s[1 * 65]); o.y = pk2(s[2 * 65], s[3 * 65]); o.z = pk2(s[4 * 65], s[5 * 65]); o.w = pk2(s[6 * 65], s[7 * 65]);
        *(GAS v4u*)(WT + (size_t)(drow0 + n) * Kd + k0 + 8 * c) = o; }
    LDS_WAIT(); asm volatile("" ::: "memory");
}
struct Ptrs {
    const float* in[N_IN]; float* out; unsigned char* ws;
};
__device__ __forceinline__ bf16* wsm(unsigned char* ws, int L, size_t off) { return (bf16*)(ws + WS_WSM + (size_t)L * WSM_LAYER + off); }
constexpr int SMALL_ITEMS = 1280 + 256 + 128 + 256, EXPERT_ITEMS = 64 * 384;
__device__ __forceinline__ void conv_small_item(int it, int L, const InTab in, unsigned char* ws, LAS float* scr, int lane) {
    if (it < 1280) { const int kb = it / 80, n0 = 64 * (it % 80); const float* W = in[I_WIN] + (size_t)L * 1024 * INW;
        if (n0 < 1536) tr_item(W, INW, 64 * kb, n0, wsm(ws, L, WSM_WINA), 1024, n0, scr, lane);
        else if (n0 < 3072) tr_item(W, INW, 64 * kb, n0, wsm(ws, L, WSM_WINU), 1024, n0 - 1536, scr, lane);
        else tr_item(W, INW, 64 * kb, n0, wsm(ws, L, WSM_WINA), 1024, n0 - 1536, scr, lane);
        return; }
    it -= 1280;
    if (it < 256) { tr_item(in[I_WAP] + (size_t)L * 1024 * 1024, 1024, 64 * (it / 16), 64 * (it % 16), wsm(ws, L, WSM_WAP), 1536, 64 * (it % 16), scr, lane); return; }
    it -= 256;
    if (it < 128) { tr_item(in[I_WHP] + (size_t)L * 512 * 1024, 1024, 64 * (it / 16), 64 * (it % 16), wsm(ws, L, WSM_WAP) + 1024, 1536, 64 * (it % 16), scr, lane); return; }
    it -= 128;
    tr_item(in[I_WOUT] + (size_t)L * 1024 * 1024, 1024, 64 * (it / 16), 64 * (it % 16), wsm(ws, L, WSM_WOUT), 1024, 64 * (it % 16), scr, lane);
}
__device__ __forceinline__ void conv_expert_item(int it, int L, const InTab in, unsigned char* ws, LAS float* scr, int lane) {
    const int e = it / 384; int r = it % 384; bf16* W13 = (bf16*)(ws + WS_W13); bf16* W2T = (bf16*)(ws + WS_W2T);
    if (r < 256) { const bool third = r >= 128; r &= 127; const int kb = r / 8, n0 = 64 * (r % 8);
        const float* W = in[third ? I_EW3 : I_EW1] + (size_t)(L * NE + e) * 1024 * 512;
        tr_item(W, 512, 64 * kb, n0, W13, 1024, e * 1024 + (n0 >> 7) * 256 + (third ? 128 : 0) + (n0 & 127), scr, lane); return; }
    r -= 256;
    tr_item(in[I_EW2] + (size_t)(L * NE + e) * 512 * 1024, 1024, 64 * (r / 16), 64 * (r % 16), W2T, 512, e * 1024 + 64 * (r % 16), scr, lane);
}
__device__ __forceinline__ void mods_partial_unit(int u, const InTab in, unsigned char* ws, int lane) {
    const int L = u / 384, r0 = u % 384, cg = r0 / 16, ks = r0 % 16, col = cg * 256 + lane * 4;
    f32x4 acc[9];
#pragma unroll
    for (int r = 0; r < 9; ++r) acc[r] = (f32x4){0.f, 0.f, 0.f, 0.f};
    const float* W = in[I_WADA] + (size_t)L * 1024 * 6144 + col; const float* cv = in[I_C]; const float* cc = in[I_CCTX];
#pragma unroll 4
    for (int kk = 0; kk < 64; ++kk) { const int k = ks * 64 + kk; const f32x4 w = *(const f32x4*)(W + (size_t)k * 6144);
#pragma unroll
        for (int r = 0; r < 9; ++r) { const float x = (r < 8) ? cv[r * 1024 + k] : cc[k]; const float s = x / (1.f + expf(-x)); acc[r] += s * w; } }
    float* P = (float*)(ws + WS_MODP) + ((size_t)(ks * 2 + L) * 9) * 6144 + col;
#pragma unroll
    for (int r = 0; r < 9; ++r) *(f32x4*)(P + (size_t)r * 6144) = acc[r];
}
__device__ __forceinline__ void h2_rows(int L, int p0, int pstride, const InTab in, unsigned char* ws, int lane) {
    const float* w1 = in[I_PW1] + (size_t)L * 33 * 64; const float* w2 = in[I_PW2] + (size_t)L * 64 * 64;
    float w1c[33], w2c[64];
#pragma unroll
    for (int i = 0; i < 33; ++i) w1c[i] = w1[i * 64 + lane];
#pragma unroll
    for (int i = 0; i < 64; ++i) w2c[i] = w2[i * 64 + lane];
    const float b1 = in[I_PB1][L * 64 + lane], f1 = in[I_PF1][L * 64 + lane], b2 = in[I_PB2][L * 64 + lane], f2 = in[I_PF2][L * 64 + lane];
    float* H2 = (float*)(ws + WS_H2) + (size_t)L * 4352 * 64;
    for (int p = p0; p < 4352; p += pstride) {
        const int Ls = p < 4096 ? 4096 : 256, pos = p < 4096 ? p : p - 4096;
        float zl = 0.f;
        if (lane == 0) zl = (float)((double)pos / (double)(Ls - 1));
        else if (lane < 33) { const int bi = (lane - 1) & 15; const double band = 1e-4 + (double)bi * ((15.0 - 1e-4) / 15.0);
            const double f = 2.0 * 3.14159265358979323846 * (double)pos * band / (double)Ls;
            zl = lane < 17 ? (float)cos(f) : (float)(-sin(f)); }
        float a = b1;
#pragma unroll
        for (int i = 0; i < 33; ++i) a += __builtin_bit_cast(float, __builtin_amdgcn_readlane(__builtin_bit_cast(int, zl), i)) * w1c[i];
        const float h1 = sinf(f1 * a);
        float a2 = b2;
#pragma unroll
        for (int i = 0; i < 64; ++i) a2 += __builtin_bit_cast(float, __builtin_amdgcn_readlane(__builtin_bit_cast(int, h1), i)) * w2c[i];
        const float h2v = sinf(f2 * a2);
        H2[(size_t)p * 64 + lane] = h2v;
        if (p < 4096) { bf16* hs = (bf16*)(ws + WS_H2S) + ((size_t)L * 4096 + p) * 256; const unsigned hi = f2bf(h2v), lo = f2bf(h2v - bf2f(hi));
            hs[lane] = (bf16)hi; hs[64 + lane] = (bf16)lo; hs[128 + lane] = (bf16)hi; hs[192 + lane] = (bf16)0; }
    }
}
struct RowVec { f32x4 v[4]; };
__device__ __forceinline__ float row_sumsq(const RowVec& x) { float s = 0.f;
#pragma unroll
    for (int j = 0; j < 4; ++j) s += (x.v[j].x * x.v[j].x + x.v[j].y * x.v[j].y) + (x.v[j].z * x.v[j].z + x.v[j].w * x.v[j].w);
    return wave_sum(s); }
__device__ __forceinline__ void row_load_bf(RowVec& x, const bf16* p, int lane) {
#pragma unroll
    for (int j = 0; j < 4; ++j) { const v2u w = *(const v2u*)(p + 4 * lane + 256 * j); x.v[j] = (f32x4){bf2f(w.x & 0xffffu), bf2f(w.x >> 16), bf2f(w.y & 0xffffu), bf2f(w.y >> 16)}; } }
__device__ __forceinline__ void row_store_bf(const RowVec& x, bf16* p, int lane) {
#pragma unroll
    for (int j = 0; j < 4; ++j) { v2u o; o.x = pk2(x.v[j].x, x.v[j].y); o.y = pk2(x.v[j].z, x.v[j].w); *(v2u*)(p + 4 * lane + 256 * j) = o; } }
__device__ __forceinline__ void row_load(RowVec& x, const float* p, int lane) {
#pragma unroll
    for (int j = 0; j < 4; ++j) x.v[j] = *(const f32x4*)(p + 4 * lane + 256 * j); }
__device__ __forceinline__ void row_combine(RowVec& x, int row, const float* g2row, unsigned char* ws, int lane) {
    const int2 s = ((const int2*)(ws + WS_TOKS))[row]; const float2 g = ((const float2*)(ws + WS_TOKG))[row];
    const bf16* Y = (const bf16*)(ws + WS_Y);
#pragma unroll
    for (int j = 0; j < 4; ++j) { const int col = 4 * lane + 256 * j;
        const v2u a = *(const v2u*)(Y + (size_t)s.x * 1024 + col), b = *(const v2u*)(Y + (size_t)s.y * 1024 + col); const f32x4 gg = *(const f32x4*)(g2row + col);
        f32x4 f;
        f.x = g.x * bf2f(a.x & 0xffffu) + g.y * bf2f(b.x & 0xffffu); f.y = g.x * bf2f(a.x >> 16) + g.y * bf2f(b.x >> 16);
        f.z = g.x * bf2f(a.y & 0xffffu) + g.y * bf2f(b.y & 0xffffu); f.w = g.x * bf2f(a.y >> 16) + g.y * bf2f(b.y >> 16);
        x.v[j] += gg * f; }
}
__device__ __forceinline__ void norm1_load(RowVec& x, int L, int row, const InTab in, unsigned char* ws, int lane) {
    const float* mods = (const float*)(ws + WS_MODS); const bf16* X = (const bf16*)(ws + WS_X);
    if (L == 0) row_load(x, row < T_LAT ? in[I_X] + (size_t)row * 1024 : in[I_CTX] + (size_t)(row - T_LAT) * 1024, lane);
    else { row_load_bf(x, X + (size_t)row * 1024, lane); row_combine(x, row, mods + (size_t)(0 * 9 + (row < T_LAT ? row / SEQ : 8)) * 6144 + 5 * 1024, ws, lane); }
}
__device__ __forceinline__ void norm1_finish(const RowVec& x, int L, int row, const float* nw, unsigned char* ws, int lane) {
    const float* mods = (const float*)(ws + WS_MODS); bf16* X = (bf16*)(ws + WS_X); bf16* HX = (bf16*)(ws + WS_HX);
    const int mr = row < T_LAT ? row / SEQ : 8;
    if (L != 0) row_store_bf(x, X + (size_t)row * 1024, lane);
    const float rstd = rsqrtf(row_sumsq(x) * (1.f / 1024.f) + EPS);
    const float* mrow = mods + (size_t)(L * 9 + mr) * 6144;
#pragma unroll
    for (int j = 0; j < 4; ++j) { const int col = 4 * lane + 256 * j; const f32x4 w = *(const f32x4*)(nw + col), sh = *(const f32x4*)(mrow + col), sc = *(const f32x4*)(mrow + 1024 + col);
        const f32x4 h = (x.v[j] * rstd * w) * (1.f + sc) + sh;
        v2u o; o.x = pk2(h.x, h.y); o.y = pk2(h.z, h.w); *(v2u*)(HX + (size_t)row * 1024 + col) = o; }
}
__device__ __forceinline__ void phase_norm1(int L, const InTab in, unsigned char* ws, int gw, int NGW, int lane) {
    const float* nw = in[I_N1W] + L * 1024;
    for (int r0 = gw; r0 < R_ALL; r0 += 2 * NGW) {
        const int r1 = r0 + NGW; const bool two = r1 < R_ALL; const int r1c = two ? r1 : r0;
        RowVec xa, xb; norm1_load(xa, L, r0, in, ws, lane); norm1_load(xb, L, r1c, in, ws, lane);
        norm1_finish(xa, L, r0, nw, ws, lane); if (two) norm1_finish(xb, L, r1c, nw, ws, lane);
    }
}
__device__ __forceinline__ void norm2_finish(const RowVec& x, int L, int row, const float* nw, unsigned char* ws, int lane) {
    const float* mods = (const float*)(ws + WS_MODS); bf16* HXS = (bf16*)(ws + WS_HXS);
    const int mr = row < T_LAT ? row / SEQ : 8;
    const float rstd = rsqrtf(row_sumsq(x) * (1.f / 1024.f) + EPS);
    const float* mrow = mods + (size_t)(L * 9 + mr) * 6144;
#pragma unroll
    for (int j = 0; j < 4; ++j) { const int col = 4 * lane + 256 * j; const f32x4 w = *(const f32x4*)(nw + col), sh = *(const f32x4*)(mrow + 3 * 1024 + col), sc = *(const f32x4*)(mrow + 4 * 1024 + col);
        const f32x4 h = (x.v[j] * rstd * w) * (1.f + sc) + sh;
        v2u o; o.x = pk2(h.x, h.y); o.y = pk2(h.z, h.w); *(v2u*)(HXS + (size_t)row * 1024 + col) = o; }
}
__device__ __forceinline__ void phase_norm2(int L, int nrows, const InTab in, unsigned char* ws, int gw, int NGW, int lane) {
    const float* nw = in[I_N2W] + L * 1024; const bf16* X = (const bf16*)(ws + WS_X);
    for (int r0 = gw; r0 < nrows; r0 += 2 * NGW) {
        const int r1 = r0 + NGW; const bool two = r1 < nrows; const int r1c = two ? r1 : r0;
        RowVec xa, xb; row_load_bf(xa, X + (size_t)r0 * 1024, lane); row_load_bf(xb, X + (size_t)r1c * 1024, lane);
        norm2_finish(xa, L, r0, nw, ws, lane); if (two) norm2_finish(xb, L, r1c, nw, ws, lane);
    }
}
__device__ __forceinline__ void final_finish(const RowVec& x, int row, const float* nw, float* out, int lane) {
    const float rstd = rsqrtf(row_sumsq(x) * (1.f / 1024.f) + EPS);
#pragma unroll
    for (int j = 0; j < 4; ++j) { const int col = 4 * lane + 256 * j; *(f32x4*)(out + (size_t)row * 1024 + col) = x.v[j] * rstd * *(const f32x4*)(nw + col); }
}
__device__ __forceinline__ void phase_final(const InTab in, float* out, unsigned char* ws, int gw, int NGW, int lane) {
    const float* mods = (const float*)(ws + WS_MODS); const float* nw = in[I_FNW]; const bf16* X = (const bf16*)(ws + WS_X);
    for (int r0 = gw; r0 < T_LAT; r0 += 2 * NGW) {
        const int r1 = r0 + NGW;
        RowVec xa, xb; row_load_bf(xa, X + (size_t)r0 * 1024, lane); row_load_bf(xb, X + (size_t)r1 * 1024, lane);
        row_combine(xa, r0, mods + (size_t)(1 * 9 + r0 / SEQ) * 6144 + 5 * 1024, ws, lane); row_combine(xb, r1, mods + (size_t)(1 * 9 + r1 / SEQ) * 6144 + 5 * 1024, ws, lane);
        final_finish(xa, r0, nw, out, lane); final_finish(xb, r1, nw, out, lane);
    }
}
__device__ __forceinline__ void phase_kpost(int L, const InTab in, unsigned char* ws, int gw, int NGW, int lane) {
    bf16* KB = (bf16*)(ws + WS_KB); const float* knw = in[I_KNW] + L * 128; const float2* rope = (const float2*)(ws + WS_ROPE);
    for (int it = gw * 64 + lane; it < NB * SKV * NKV; it += NGW * 64) {
        const int kvrow = it >> 1, hd = it & 1, t = kvrow % SKV;
        v4u* p = (v4u*)(KB + (size_t)kvrow * 256 + hd * 128);
        v4u raw[16]; float ss = 0.f;
#pragma unroll
        for (int q = 0; q < 16; ++q) { raw[q] = p[q];
#pragma unroll
            for (int i = 0; i < 4; ++i) { const float a = bf2f(raw[q][i] & 0xffffu), b = bf2f(raw[q][i] >> 16); ss += a * a + b * b; } }
        const float rstd = rsqrtf(ss * (1.f / 128.f) + EPS);
        const bool lat = t < SEQ; const float2* tr = rope + (t >> 6) * 32; const float2* tc = rope + (t & 63) * 32;
#pragma unroll
        for (int q = 0; q < 8; ++q) {
            v4u wa, wb;
#pragma unroll
            for (int i = 0; i < 4; ++i) { const int j = 8 * q + 2 * i;
                float a0 = bf2f(raw[q][i] & 0xffffu) * rstd * knw[j], a1 = bf2f(raw[q][i] >> 16) * rstd * knw[j + 1];
                float b0 = bf2f(raw[q + 8][i] & 0xffffu) * rstd * knw[j + 64], b1 = bf2f(raw[q + 8][i] >> 16) * rstd * knw[j + 65];
                if (lat) { const float2 c0 = j < 32 ? tr[j] : tc[j - 32], c1 = j < 32 ? tr[j + 1] : tc[j - 31];
                    const float x0 = a0 * c0.x - b0 * c0.y, y0 = a0 * c0.y + b0 * c0.x, x1 = a1 * c1.x - b1 * c1.y, y1 = a1 * c1.y + b1 * c1.x; a0 = x0; b0 = y0; a1 = x1; b1 = y1; }
                wa[i] = pk2(a0, a1); wb[i] = pk2(b0, b1); }
            p[q] = wa; p[q + 8] = wb; }
    }
}
__device__ __forceinline__ void phase_transpose(unsigned char* ws, LAS unsigned char* lds, int wave, int gw, int NGW, int lane) {
    const bf16* YHT = (const bf16*)(ws + WS_YHT); bf16* YH = (bf16*)(ws + WS_OY) + 1024;
    LAS bf16* tile = (LAS bf16*)(lds + wave * 9216);
    for (int it = gw; it < 8 * (R_ALL / 64); it += NGW) {
        const int cb = it & 7, rb = it >> 3;
#pragma unroll
        for (int i = 0; i < 8; ++i) { const int ch = i * 8 + (lane >> 3), tk = (lane & 7) * 8;
            const v4u w = *(const v4u*)(YHT + (size_t)(cb * 64 + ch) * R_ALL + rb * 64 + tk);
#pragma unroll
            for (int q = 0; q < 4; ++q) { tile[(tk + 2 * q) * 72 + ch] = (bf16)(w[q] & 0xffffu); tile[(tk + 2 * q + 1) * 72 + ch] = (bf16)(w[q] >> 16); } }
        LDS_WAIT(); asm volatile("" ::: "memory");
#pragma unroll
        for (int i = 0; i < 8; ++i) { const int tk = i * 8 + (lane >> 3), c8 = (lane & 7) * 8;
            const v4u w = *(const LAS v4u*)(tile + tk * 72 + c8);
            *(v4u*)(YH + (size_t)(rb * 64 + tk) * 1536 + cb * 64 + c8) = w; }
        LDS_WAIT(); asm volatile("" ::: "memory");
    }
}
__device__ __forceinline__ float hy_delta(int c) { return 3.070113457325394f + (float)c * 0.024032199274562772f; }
typedef _Float16 hy_h2 __attribute__((ext_vector_type(2)));
__device__ __forceinline__ unsigned hy_pkh(f32x2 x) { return __builtin_bit_cast(unsigned, (hy_h2){(_Float16)x.x, (_Float16)x.y}); }
__device__ __forceinline__ f32x2 hy_uph(unsigned w) { const hy_h2 h = __builtin_bit_cast(hy_h2, w); return (f32x2){(float)h.x, (float)h.y}; }
__device__ __forceinline__ void filter_fft_unit(int c, int L, const InTab in, unsigned char* ws, LAS unsigned char* lds, int tid, const FftTw& tw) {
    LAS f32x2* Lb = (LAS f32x2*)lds;
    const float* F = (const float*)(ws + WS_FT) + (size_t)L * 2048 * 4096;
    v2u* K = (v2u*)(ws + WS_KSPEC);
    __syncthreads();
#pragma unroll 1
    for (int o = 0; o < 2; ++o) {
        const float* hf = F + (size_t)(o * 1024 + c) * 4096; const float* hb = F + (size_t)(o * 1024 + 512 + c) * 4096;
        f32x2 v[16];
#pragma unroll
        for (int n1 = 0; n1 < 8; ++n1) v[n1] = (f32x2){hf[512 * n1 + tid], 0.f};
        v[8] = (f32x2){tid == 0 ? 0.f : hb[4096 - tid], 0.f};
#pragma unroll
        for (int n1 = 9; n1 < 16; ++n1) v[n1] = (f32x2){hb[512 * (16 - n1) - tid], 0.f};
        fft_fwd<true>(tid, v, tw, Lb);
#pragma unroll
        for (int a = 0; a < 8; ++a) { const f32x2 u0 = v[2 * a] * (1.f / 64.f), u1 = v[2 * a + 1] * (1.f / 64.f);
            K[((size_t)(c * 2 + o) * 8 + a) * 512 + tid] = (v2u){hy_pkh(u0), hy_pkh(u1)}; }
    }
}
__device__ __forceinline__ float sconv(const bf16* row, int t, int len, float w0, float w1, float w2, float b) {
    const float l = t > 0 ? bf2f(row[t - 1]) : 0.f, m = bf2f(row[t]), r = t < len - 1 ? bf2f(row[t + 1]) : 0.f;
    return l * w0 + m * w1 + r * w2 + b;
}
__device__ __forceinline__ float sconv3(const bf16* tp, int off, bool lv, bool rv, float w0, float w1, float w2, float b) {
    const unsigned l = tp[off - 1], m = tp[off], r = tp[off + 1];
    return (lv ? bf2f(l) : 0.f) * w0 + bf2f(m) * w1 + (rv ? bf2f(r) : 0.f) * w2 + b;
}
struct __attribute__((packed, aligned(4))) HyU3 { unsigned a, b, c; };
__device__ __forceinline__ f32x2 sconv3x2u(const HyU3 u, bool lv, bool rv, float w0, float w1, float w2, float b) {
    const float em = __uint_as_float(u.a & 0xffff0000u), e0 = __uint_as_float(u.b << 16), e1 = __uint_as_float(u.b & 0xffff0000u), e2 = __uint_as_float(u.c << 16);
    return (f32x2){(lv ? em : 0.f) * w0 + e0 * w1 + e1 * w2 + b, e0 * w0 + e1 * w1 + (rv ? e2 : 0.f) * w2 + b};
}
__device__ __forceinline__ f32x2 sconv3x2(const bf16* tp, int off, bool lv, bool rv, float w0, float w1, float w2, float b) { return sconv3x2u(*(const HyU3*)(tp + off - 2), lv, rv, w0, w1, w2, b); }
__device__ __forceinline__ void gbar(volatile LAS unsigned* cnt, unsigned& epoch, int lane) {
    asm volatile("s_waitcnt lgkmcnt(0)" ::: "memory");
    epoch += 4u;
    if (lane == 0) (void)__hip_atomic_fetch_add((LAS unsigned*)cnt, 1u, __ATOMIC_RELAXED, __HIP_MEMORY_SCOPE_WORKGROUP);
    while ((unsigned)__builtin_amdgcn_readfirstlane(*cnt) < epoch) __builtin_amdgcn_s_sleep(1);
    asm volatile("" ::: "memory");
}
__device__ __forceinline__ void hyena_unit(int c, int L, const InTab in, unsigned char* ws, LAS unsigned char* lds, int tid, volatile LAS unsigned* gcnt, unsigned& epoch) {
    const int g = tid >> 8, t0 = tid & 255, t1 = t0 + 256, lane = tid & 63;
    LAS f32x2* Lb = (LAS f32x2*)(lds + g * 67584); volatile LAS unsigned* cnt = gcnt + 16 * g;
    FftTw twA = fft_tw_init(t0); twA.wA = cispi(-2.f * (float)(2 * t0) / 8192.f);
    FftTw twB = twA; { const int m2 = t1 & 31, k1 = t1 >> 5; twB.wI2b = cispi(-2.f * (float)((m2 * k1) & 8191) / 8192.f); }
    const float* cw = in[I_HCW] + (size_t)L * 3 * 1536; const float* cb = in[I_HCB] + (size_t)L * 1536; const float* sk = in[I_SKIP] + (size_t)L * 2 * 512;
    const float a0 = cw[c], a1 = cw[1536 + c], a2 = cw[3072 + c], ab = cb[c];
    const float b0 = cw[512 + c], b1 = cw[1536 + 512 + c], b2 = cw[3072 + 512 + c], bb = cb[512 + c];
    const float v0 = cw[1024 + c], v1 = cw[1536 + 1024 + c], v2 = cw[3072 + 1024 + c], vb = cb[1024 + c];
    const float skip0 = sk[c], skip1 = sk[512 + c];
    const bf16* UT = (const bf16*)(ws + WS_UT); bf16* YHT = (bf16*)(ws + WS_YHT);
    const v2u* K1 = (const v2u*)(ws + WS_KSPEC) + (size_t)(c * 2 + 0) * 8 * 512; const v2u* K2 = K1 + 8 * 512;
#define KP_PUT(arr, n1, val) arr[n1] = __builtin_bit_cast(unsigned, __builtin_amdgcn_cvt_pkrtz((val).x, (val).y))
#define KP_GET(arr, n1) ({ const __fp16 __attribute__((ext_vector_type(2))) h_ = __builtin_bit_cast(__fp16 __attribute__((ext_vector_type(2))), arr[n1]); (f32x2){(float)h_.x, (float)h_.y}; })
#pragma unroll 1
    for (int pp = 0; pp < 2; ++pp) {
        const int p = 2 * g + pp;
        const bf16* x1r = UT + (size_t)c * R_ALL + (size_t)(2 * p) * SEQ; const bf16* x2r = UT + (size_t)(512 + c) * R_ALL + (size_t)(2 * p) * SEQ; const bf16* vr = UT + (size_t)(1024 + c) * R_ALL + (size_t)(2 * p) * SEQ;
        bf16* yr = YHT + (size_t)c * R_ALL + (size_t)(2 * p) * SEQ;
        int tp = t0; asm volatile("" : "+v"(tp));
        f32x2 vA[16], vB[16]; unsigned kA[8], kB[8];
        { const bf16* vt = vr + 2 * tp;
#pragma unroll
          for (int n1 = 0; n1 < 8; ++n1) { const bool lv = !(n1 == 0 && t0 == 0), rv = !(n1 == 7 && t0 == 255);
            const f32x2 c0 = sconv3x2(vt, 512 * n1, lv, rv, v0, v1, v2, vb), c1 = sconv3x2(vt + SEQ, 512 * n1, lv, rv, v0, v1, v2, vb);
            vA[n1] = (f32x2){c0.x, c1.x}; vB[n1] = (f32x2){c0.y, c1.y}; KP_PUT(kA, n1, vA[n1]); KP_PUT(kB, n1, vB[n1]); } }
#pragma unroll
        for (int n1 = 8; n1 < 16; ++n1) { vA[n1] = (f32x2){0.f, 0.f}; vB[n1] = (f32x2){0.f, 0.f}; }
#define HY_CONV(K, ROWP) \
        fft_fA(2 * t0, vA, twA, Lb); fft_fA<1>(2 * t0 + 1, vB, twA, Lb); \
        v2u kq[16]; _Pragma("unroll") for (int a = 0; a < 8; ++a) { kq[2 * a] = K[a * 512 + tp]; kq[2 * a + 1] = K[a * 512 + 256 + tp]; } \
        gbar(cnt, epoch, lane); fft_fC1(t0, twA, Lb); fft_fC1(t1, twB, Lb); gbar(cnt, epoch, lane); fft_fC3(t0, vA, Lb); fft_fC3(t1, vB, Lb); \
        _Pragma("unroll") for (int a = 0; a < 8; ++a) { const v2u ka = kq[2 * a], kb = kq[2 * a + 1]; \
            vA[2 * a] = cmul(vA[2 * a], hy_uph(ka.x)); vA[2 * a + 1] = cmul(vA[2 * a + 1], hy_uph(ka.y)); vB[2 * a] = cmul(vB[2 * a], hy_uph(kb.x)); vB[2 * a + 1] = cmul(vB[2 * a + 1], hy_uph(kb.y)); } \
        fft_iI1(t0, vA, twA, Lb); fft_iI1(t1, vB, twB, Lb); \
        HyU3 u0[8], u1[8]; _Pragma("unroll") for (int n1 = 0; n1 < 8; ++n1) { u0[n1] = *(const HyU3*)((ROWP) + 512 * n1 - 2); u1[n1] = *(const HyU3*)((ROWP) + SEQ + 512 * n1 - 2); } \
        gbar(cnt, epoch, lane); fft_iI2(t0, twA, Lb); fft_iI2<true>(t1, twB, Lb); gbar(cnt, epoch, lane); fft_iI3(2 * t0, vA, Lb); fft_iI3(2 * t0 + 1, vB, Lb)
        { HY_CONV(K1, x1r + 2 * tp);
#pragma unroll
          for (int n1 = 0; n1 < 8; ++n1) { const bool lv = !(n1 == 0 && t0 == 0), rv = !(n1 == 7 && t0 == 255);
            const f32x2 c0 = sconv3x2u(u0[n1], lv, rv, a0, a1, a2, ab), c1 = sconv3x2u(u1[n1], lv, rv, a0, a1, a2, ab);
            const f32x2 xa = (f32x2){c0.x, c1.x}, xb = (f32x2){c0.y, c1.y};
            vA[n1] = xa * (vA[n1] * (1.f / 128.f) + skip0 * KP_GET(kA, n1)); vB[n1] = xb * (vB[n1] * (1.f / 128.f) + skip0 * KP_GET(kB, n1)); KP_PUT(kA, n1, vA[n1]); KP_PUT(kB, n1, vB[n1]); } }
#pragma unroll
        for (int n1 = 8; n1 < 16; ++n1) { vA[n1] = (f32x2){0.f, 0.f}; vB[n1] = (f32x2){0.f, 0.f}; }
        { HY_CONV(K2, x2r + 2 * tp); bf16* yt = yr + 2 * tp;
#pragma unroll
          for (int n1 = 0; n1 < 8; ++n1) { const bool lv = !(n1 == 0 && t0 == 0), rv = !(n1 == 7 && t0 == 255);
            const f32x2 c0 = sconv3x2u(u0[n1], lv, rv, b0, b1, b2, bb), c1 = sconv3x2u(u1[n1], lv, rv, b0, b1, b2, bb);
            const f32x2 xa = (f32x2){c0.x, c1.x}, xb = (f32x2){c0.y, c1.y};
            const f32x2 ya = xa * (vA[n1] * (1.f / 128.f) + skip1 * KP_GET(kA, n1)), yb = xb * (vB[n1] * (1.f / 128.f) + skip1 * KP_GET(kB, n1));
            *(unsigned*)(yt + 512 * n1) = pk2(ya.x, yb.x); *(unsigned*)(yt + SEQ + 512 * n1) = pk2(ya.y, yb.y); } }
    }
#undef HY_CONV
#undef KP_PUT
#undef KP_GET
}
__device__ __forceinline__ void hyena_ctx_conv(const LAS float* G, const LAS float* src  , LAS float* P  , int tid) {
    const int h = tid >> 8, t = tid & 255;
    f32x4 a0 = (f32x4){0.f, 0.f, 0.f, 0.f}, a1 = a0;
    const LAS float* g = G + 255 - t + 128 * h; const LAS f32x4* sv = (const LAS f32x4*)(src + 128 * h * 8);
#pragma unroll 8
    for (int s = 0; s < 128; ++s) { const float k = g[s]; a0 += k * sv[2 * s]; a1 += k * sv[2 * s + 1]; }
    LAS f32x4* o = (LAS f32x4*)(P + (h * 256 + t) * 8); o[0] = a0; o[1] = a1;
}
__device__ __forceinline__ void hyena_ctx_unit(int c, int L, const InTab in, unsigned char* ws, LAS unsigned char* lds, int tid) {
    LAS float* G1 = (LAS float*)lds;
    LAS float* G2 = G1 + 512;
    LAS float* vv = G2 + 512;
    LAS float* zz = vv + 2048;
    LAS float* P = zz + 2048;
    const float* w3 = in[I_PW3] + (size_t)L * 64 * 2048; const float* H2 = (const float*)(ws + WS_H2) + ((size_t)L * 4352 + 4096) * 64;
    const float* cw = in[I_HCW] + (size_t)L * 3 * 1536; const float* cb = in[I_HCB] + (size_t)L * 1536; const float* sk = in[I_SKIP] + (size_t)L * 2 * 512;
    const float a0 = cw[c], a1 = cw[1536 + c], a2 = cw[3072 + c], ab = cb[c];
    const float b0 = cw[512 + c], b1 = cw[1536 + 512 + c], b2 = cw[3072 + 512 + c], bb = cb[512 + c];
    const float v0 = cw[1024 + c], v1 = cw[1536 + 1024 + c], v2 = cw[3072 + 1024 + c], vb = cb[1024 + c];
    const float skip0 = sk[c], skip1 = sk[512 + c], delta = hy_delta(c);
    const bf16* UT = (const bf16*)(ws + WS_UT); bf16* YHT = (bf16*)(ws + WS_YHT);
    const bf16* x1r = UT + (size_t)c * R_ALL + T_LAT; const bf16* x2r = UT + (size_t)(512 + c) * R_ALL + T_LAT; const bf16* vr = UT + (size_t)(1024 + c) * R_ALL + T_LAT;
    __syncthreads();
    for (int idx = tid; idx < 1024; idx += NTHR) { const int od = idx >> 8, t = idx & 255; const float* row = H2 + (size_t)t * 64; float d = 0.f;
        for (int j = 0; j < 64; ++j) d += row[j] * w3[(size_t)j * 2048 + od * 512 + c];
        d *= expf(-((float)t / 255.f) * delta);
        LAS float* G = (od & 2) ? G2 : G1;
        if (od & 1) { if (t > 0) G[255 + t] = d; } else G[255 - t] = d; }
    for (int idx = tid; idx < 2048; idx += NTHR) { const int b = idx >> 8, t = idx & 255; vv[t * 8 + b] = sconv(vr + b * 256, t, 256, v0, v1, v2, vb); }
    __syncthreads();
    hyena_ctx_conv(G1, vv, P, tid);
    __syncthreads();
    for (int idx = tid; idx < 2048; idx += NTHR) { const int b = idx & 7, t = idx >> 3; const float y = P[t * 8 + b] + P[2048 + t * 8 + b];
        zz[t * 8 + b] = sconv(x1r + b * 256, t, 256, a0, a1, a2, ab) * (y + skip0 * vv[t * 8 + b]); }
    __syncthreads();
    hyena_ctx_conv(G2, zz, P, tid);
    __syncthreads();
    for (int idx = tid; idx < 2048; idx += NTHR) { const int b = idx & 7, t = idx >> 3; const float y = P[t * 8 + b] + P[2048 + t * 8 + b];
        YHT[(size_t)c * R_ALL + T_LAT + b * 256 + t] = (bf16)f2bf(sconv(x2r + b * 256, t, 256, b0, b1, b2, bb) * (y + skip1 * zz[t * 8 + b])); }
    __syncthreads();
}
__device__ __forceinline__ void phase_gather(int npan, unsigned char* ws, LAS unsigned char* lds, int wg, int tid) {
    LAS int* tot = (LAS int*)lds; LAS int* basew = tot + 64; LAS int* pstart = tot + 128; LAS int* part = tot + 256;
    const unsigned* hist = (const unsigned*)(ws + WS_HIST);
    __syncthreads();
    { const int e = tid & 63, w0 = tid >> 6; int t = 0, b = 0;
#pragma unroll 4
      for (int w = w0; w < npan; w += 8) { const int h = (int)hist[w * 64 + e]; t += h; b += (w < wg) ? h : 0; }
      part[w0 * 128 + e] = t; part[w0 * 128 + 64 + e] = b; }
    __syncthreads();
    if (tid < 64) { int t = 0, b = 0;
#pragma unroll
        for (int k = 0; k < 8; ++k) { t += part[k * 128 + tid]; b += part[k * 128 + 64 + tid]; }
        tot[tid] = t; basew[tid] = b; }
    __syncthreads();
    if (tid == 0) { int acc = 0; for (int e = 0; e < 64; ++e) { pstart[e] = acc; acc += (tot[e] + 255) / 256 * 256; } pstart[64] = acc; }
    __syncthreads();
    int* stok = (int*)(ws + WS_STOK);
    if (wg == 255 && tid < 64) { int* be = (int*)(ws + WS_BLKE); for (int b = pstart[tid] / 256; b < pstart[tid + 1] / 256; ++b) be[b] = tid; if (tid == 0) be[512] = pstart[64] / 256; }
    if (wg >= 192) { const int e = wg - 192; for (int s = pstart[e] + tot[e] + tid; s < pstart[e + 1]; s += NTHR) stok[s] = 0; }
    if (wg < npan && tid < 256) { const int tok = wg * 256 + tid;
        const int2 e = ((const int2*)(ws + WS_TOKE))[tok], r = ((const int2*)(ws + WS_TOKR))[tok];
        const int s0 = pstart[e.x] + basew[e.x] + r.x, s1 = pstart[e.y] + basew[e.y] + r.y;
        ((int2*)(ws + WS_TOKS))[tok] = make_int2(s0, s1); stok[s0] = tok; stok[s1] = tok; }
    __syncthreads();
}

constexpr int NPHASES = 27;
struct Args { const float* in[N_IN]; float* out; unsigned char* ws; int ph_lo, ph_hi; };
static_assert(sizeof(Args) == N_IN * 8 + 8 + 8 + 8, "Args has no padding");

__global__ void __launch_bounds__(NTHR, 2) fwd_kernel(Args args) {
    extern __shared__ __attribute__((aligned(16))) unsigned char lds_raw[];
    LAS unsigned char* lds = (LAS unsigned char*)lds_raw;
    volatile LAS unsigned* MISC = (volatile LAS unsigned*)(lds + MISC_OFF);
    const int tid0 = threadIdx.x; const int wave0 = __builtin_amdgcn_readfirstlane(tid0 >> 6);
    constexpr int G = 256, NGW = G * NWAVES;
    const int wg0 = blockIdx.x;
#define PH_IDS() int tid; asm volatile("v_mbcnt_lo_u32_b32 %0, -1, 0\n\tv_mbcnt_hi_u32_b32 %0, -1, %0\n\tv_lshl_or_b32 %0, %1, 6, %0" : "=&v"(tid) : "s"(wave0));     const int wg = opaque_u32(wg0); const int lane = tid & 63, wave = __builtin_amdgcn_readfirstlane(tid >> 6), gw = wg * NWAVES + wave; (void)lane; (void)gw; \
    unsigned char* ws = ws0 + (size_t)(unsigned)opaque_u32(0);     const InTab in{(LAS const unsigned long long*)(lds + PTAB_OFF)}; (void)in
    unsigned char* const ws0 = args.ws;
    for (int u = tid0; u < (LDS_BYTES - RING_BYTES) / 4; u += NTHR) ((LAS unsigned*)(lds + RING_BYTES))[u] = 0u;
    __syncthreads();
    if (tid0 == 0) { LAS unsigned long long* pt = (LAS unsigned long long*)(lds + PTAB_OFF);
#pragma unroll
        for (int i = 0; i < N_IN; ++i) pt[i] = (unsigned long long)(uintptr_t)args.in[i]; }
    __syncthreads();
    unsigned* ctl = (unsigned*)(ws0 + WS_CTL); (void)ctl;
#if MK_PER_PHASE
#define GRID_BAR() do { } while (0)
#else
    XcdBarrier bar = xcd_barrier_post(ctl + CW_BAR, MISC + 8, wave0);
#define GRID_BAR() xcd_barrier(bar)
#endif
    const int lo = args.ph_lo, hi = args.ph_hi;
#define IN(k) (lo <= (k) && (k) < hi)
#ifdef PROBE_MASK
    unsigned long long probe_t0 = __builtin_amdgcn_s_memrealtime();
#define SEAM(k) do { if (IN(k) && IN((k) + 1)) GRID_BAR(); { const unsigned long long t1_ = __builtin_amdgcn_s_memrealtime(); \
        if ((PROBE_MASK >> (k)) & 1ull) { const unsigned long long w_ = 4ull * (t1_ - probe_t0); while (__builtin_amdgcn_s_memrealtime() - t1_ < w_) __builtin_amdgcn_s_sleep(8); } \
        probe_t0 = __builtin_amdgcn_s_memrealtime(); } } while (0)
#else
#define SEAM(k) do { if (IN(k) && IN((k) + 1)) GRID_BAR(); } while (0)
#endif

    if (IN(0)) { PH_IDS();
        for (int u = gw; u < 768; u += NGW) mods_partial_unit(u, in, ws, lane);
        if (gw >= 768 && gw < 768 + 512) h2_rows((gw - 768) >> 8, (gw - 768) & 255, 256, in, ws, lane);
        for (int i = wg * NTHR + tid; i < 2048; i += G * NTHR) { const int v = i >> 5, j = i & 31; const double ang = (double)v * pow(10000.0, -(double)j / 32.0);
            ((float2*)(ws + WS_ROPE))[i] = make_float2((float)cos(ang), (float)sin(ang)); }
        { const float* rw = in[I_RW]; bf16* BTR = (bf16*)(ws + WS_BTR);
          for (int i = wg * NTHR + tid; i < 256 * 1024; i += G * NTHR) { const int row = i >> 10, k = i & 1023; BTR[i] = (bf16)(row < 64 ? f2bf(rw[(size_t)k * 64 + row]) : 0u); } }
        { const float* w3 = in[I_PW3]; bf16* W3S = (bf16*)(ws + WS_W3S);
          for (int i = wg * NTHR + tid; i < 2 * 2048 * 256; i += G * NTHR) { const int L = i >> 19, col = (i >> 8) & 2047, k = i & 255, j = k & 63, part = k >> 6;
              const float w = w3[((size_t)L * 64 + j) * 2048 + col]; const unsigned hi = f2bf(w); W3S[i] = (bf16)(part < 2 ? hi : part == 2 ? f2bf(w - bf2f(hi)) : 0u); } }
        LAS float* scr = (LAS float*)(lds + wave * 16896);
        for (int it = gw; it < 2 * SMALL_ITEMS; it += NGW) conv_small_item(it % SMALL_ITEMS, it / SMALL_ITEMS, in, ws, scr, lane);
        for (int it = gw; it < EXPERT_ITEMS; it += NGW) conv_expert_item(it, 0, in, ws, scr, lane);
    }
    SEAM(0);
    if (IN(1)) { PH_IDS();
        const float* P = (const float*)(ws + WS_MODP); float* M = (float*)(ws + WS_MODS);
        for (int i = wg * NTHR + tid; i < 2 * 9 * 6144; i += G * NTHR) { const int L = i / (9 * 6144), col = i % 6144; float s = in[I_BADA][L * 6144 + col];
            for (int ks = 0; ks < 16; ++ks) s += P[((size_t)(ks * 2 + L) * 9 + (i / 6144) % 9) * 6144 + col];
            M[i] = s; }
        { pg8::Gemm g{(const bf16*)(ws + WS_W3S), (const bf16*)(ws + WS_H2S), 2 * 2048, 2 * 4096, 256}; pg8::FiltOrder S{wg}; pg8::EpiFilt E{(float*)(ws + WS_FT)};
          __syncthreads(); pg8::gemm_phase<pg8::EpiFilt, pg8::FiltOrder, true, true>(lds, g, S, E, tid); }
    }
    SEAM(1);
    for (int L = 0; L < 2; ++L) {
        const int pb = 2 + 12 * L;
        const int nrows = L == 0 ? R_ALL : T_LAT;
        if (IN(pb + 0)) { PH_IDS();
            phase_norm1(L, in, ws, gw, NGW, lane);
            if (L == 1) {
                GRID_BAR();
                if (wg >= G - 16) { constexpr size_t TS = 512 * 1024; const int hx0 = (int)(WS_HX / TS), wa0 = (int)((WS_WSM + (size_t)L * WSM_LAYER + WSM_WINA) / TS), wu0 = (int)((WS_WSM + (size_t)L * WSM_LAYER + WSM_WINU) / TS);
                    pg8::Gemm g{(const bf16*)ws, (const bf16*)ws, 0, 0, DM}; pg8::CtxKVOrder S{hx0, wa0, wg - (G - 16)};
                    pg8::EpiGemm1 E{pg8::EpiQKVG{(bf16*)(ws + WS_Q), (bf16*)(ws + WS_KB), (bf16*)(ws + WS_VB), (bf16*)(ws + WS_G)}, pg8::EpiStoreBf16{(bf16*)(ws + WS_UT), R_ALL, 0x7fffffff}, hx0, wa0, wu0};
                    pg8::gemm_phase<pg8::EpiGemm1, pg8::CtxKVOrder, true, true>(lds, g, S, E, tid); }
                __syncthreads();
            }
            { const FftTw tw = fft_tw_init(tid); for (int c = wg; c < HYW; c += G) filter_fft_unit(c, L, in, ws, lds, tid, tw); }
            __syncthreads();
            if (L == 1 && wg < G - 16) { LAS float* scr = (LAS float*)(lds + wave * 16896); for (int it = gw; it < EXPERT_ITEMS; it += NGW - 16 * NWAVES) conv_expert_item(it, 1, in, ws, scr, lane); }
        }
        SEAM(pb + 0);
        if (IN(pb + 1)) { PH_IDS(); (void)tid; (void)wave;
            constexpr size_t TS = 512 * 1024;
            static_assert(WS_HX % TS == 0 && WS_WSM % TS == 0 && WSM_LAYER % TS == 0 && WSM_WINU % TS == 0, "GEMM1 tile space");
            const int hx0 = (int)(WS_HX / TS), wa0 = (int)((WS_WSM + (size_t)L * WSM_LAYER + WSM_WINA) / TS), wu0 = (int)((WS_WSM + (size_t)L * WSM_LAYER + WSM_WINU) / TS);
            pg8::Gemm g{(const bf16*)ws, (const bf16*)ws, 0, 0, DM}; pg8::Gemm1Order S; S.init(hx0, wa0, wu0, G, wg, L == 0 ? 136 : 128);
            pg8::EpiGemm1 E{pg8::EpiQKVG{(bf16*)(ws + WS_Q), (bf16*)(ws + WS_KB), (bf16*)(ws + WS_VB), (bf16*)(ws + WS_G)}, pg8::EpiStoreBf16{(bf16*)(ws + WS_UT), R_ALL, 0x7fffffff}, hx0, wa0, wu0};
            pg8::gemm_phase<pg8::EpiGemm1, pg8::Gemm1Order, true, true>(lds, g, S, E, tid);
        }
        SEAM(pb + 1);
        if (IN(pb + 2)) { PH_IDS();
            phase_kpost(L, in, ws, gw, NGW, lane);
            { volatile LAS unsigned* gcnt = (volatile LAS unsigned*)(lds + RING_BYTES + 2048); unsigned epoch = 0u;
              __syncthreads(); if (tid == 0) { gcnt[0] = 0u; gcnt[16] = 0u; } __syncthreads();
              for (int c = wg; c < HYW; c += G) hyena_unit(c, L, in, ws, lds, tid, gcnt, epoch);
              __syncthreads(); }
            if (L == 0) for (int c = wg; c < HYW; c += G) hyena_ctx_unit(c, L, in, ws, lds, tid);
        }
        SEAM(pb + 2);
        if (IN(pb + 3)) { { PH_IDS(); (void)tid; (void)wave;
            const int vcu = (G % 8 == 0) ? (wg % 8) * (G / 8) + wg / 8 : wg;
            const attn::bf16* Q = (const attn::bf16*)(ws + WS_Q); attn::bf16* OY = (attn::bf16*)(ws + WS_OY); const attn::bf16* KB = (const attn::bf16*)(ws + WS_KB); const attn::bf16* VB = (const attn::bf16*)(ws + WS_VB);
            const float* qnw = in[I_QNW] + L * 128; const float2* rope = (const float2*)(ws + WS_ROPE);
            __syncthreads();
            for (int u = vcu; u < 1024; u += G) {
                const int qb = u & 15, hg = (u >> 4) & 3, kvh = (u >> 6) & 1, b = u >> 7, h = kvh * 4 + hg;
                attn::attn_dense_body(Q + (size_t)(b * SEQ + qb * 256) * 1024 + h * 128, OY + (size_t)(b * SEQ + qb * 256) * 1536 + h * 128, KB + (size_t)b * SKV * 256 + kvh * 128, VB + (size_t)b * SKV * 256 + kvh * 128, SKV, (char*)lds_raw, qnw, rope, qb * 256, wave0);
            }
            if (L == 0) for (int u = vcu; u < 64; u += G) { const int h = u & 7, b = u >> 3, kvh = h >> 2;
                attn::attn_dense_body(Q + (size_t)(T_LAT + b * CL) * 1024 + h * 128, OY + (size_t)(T_LAT + b * CL) * 1536 + h * 128, KB + ((size_t)b * SKV + SEQ) * 256 + kvh * 128, VB + ((size_t)b * SKV + SEQ) * 256 + kvh * 128, CL, (char*)lds_raw, qnw, nullptr, 0, wave0); }
            }
            { PH_IDS(); (void)tid; phase_transpose(ws, lds, wave, gw, NGW, lane); }
        }
        SEAM(pb + 3);
        if (IN(pb + 4)) { PH_IDS(); (void)tid; (void)wave;
            pg8::Gemm g{(const bf16*)(ws + WS_OY), wsm(ws, L, WSM_WAP), nrows, DM, DM + HYW}; pg8::StaticOrder S; S.init(nrows, DM, G, wg);
            pg8::EpiMergeCat E{(bf16*)(ws + WS_MG), (const bf16*)(ws + WS_G)};
            pg8::gemm_phase<pg8::EpiMergeCat, pg8::StaticOrder, true, true>(lds, g, S, E, tid);
        }
        SEAM(pb + 4);
        if (IN(pb + 5)) { PH_IDS(); (void)tid; (void)wave;
            pg8::Gemm g{(const bf16*)(ws + WS_MG), wsm(ws, L, WSM_WOUT), nrows, DM, DM}; pg8::StaticOrder S; S.init(nrows, DM, G, wg);
            bf16* X = (bf16*)(ws + WS_X); const float* g1 = (const float*)(ws + WS_MODS) + (size_t)L * 9 * 6144 + 2 * 1024;
            if (L == 0) { pg8::EpiResid<false> E{(const void*)in[I_X], (const void*)in[I_CTX], X, g1}; pg8::gemm_phase<pg8::EpiResid<false>, pg8::StaticOrder, true, true>(lds, g, S, E, tid); }
            else { pg8::EpiResid<true> E{(const void*)X, (const void*)(X + (size_t)T_LAT * 1024), X, g1}; pg8::gemm_phase<pg8::EpiResid<true>, pg8::StaticOrder, true, true>(lds, g, S, E, tid); }
        }
        SEAM(pb + 5);
        if (IN(pb + 6)) { PH_IDS(); phase_norm2(L, nrows, in, ws, gw, NGW, lane); }
        SEAM(pb + 6);
        if (IN(pb + 7)) { PH_IDS(); (void)tid; (void)wave;
            pg8::Gemm g{(const bf16*)(ws + WS_HXS), (const bf16*)(ws + WS_BTR), nrows, 256, 1024}; pg8::StaticOrder S; S.init(nrows, 256, G, wg);
            pg8::EpiTopK E{in[I_RB], (int*)(ws + WS_TOKE), (float*)(ws + WS_TOKG), (int*)(ws + WS_TOKR), (unsigned*)(ws + WS_HIST)};
            pg8::gemm_phase<pg8::EpiTopK, pg8::StaticOrder, true, true>(lds, g, S, E, tid);
        }
        SEAM(pb + 7);
        if (IN(pb + 9)) { PH_IDS(); phase_gather(nrows / 256, ws, lds, wg, tid); }
        SEAM(pb + 9);
        if (IN(pb + 10)) { PH_IDS(); (void)tid; (void)wave;
            const int* be = (const int*)(ws + WS_BLKE); const int nblk = be[512];
            pg8::Gemm g{(const bf16*)(ws + WS_HXS), (const bf16*)(ws + WS_W13), nblk * 256, 1024, DM}; pg8::MoeGatherOrder S; S.init(nblk, be, G, wg, (const int*)(ws + WS_STOK), 2048);
            pg8::EpiSwiGLU E{(bf16*)(ws + WS_HMID)};
            pg8::gemm_phase<pg8::EpiSwiGLU, pg8::MoeGatherOrder, true, true>(lds, g, S, E, tid);
        }
        SEAM(pb + 10);
        if (IN(pb + 11)) { PH_IDS(); (void)tid; (void)wave;
            const int* be = (const int*)(ws + WS_BLKE); const int nblk = be[512];
            pg8::Gemm g{(const bf16*)(ws + WS_HMID), (const bf16*)(ws + WS_W2T), nblk * 256, 1024, EDIM}; pg8::MoeOrder S; S.init(nblk, be, G, wg);
            pg8::EpiStoreBf16 E{(bf16*)(ws + WS_Y), 1024, 3};
            pg8::gemm_phase<pg8::EpiStoreBf16, pg8::MoeOrder, true, true>(lds, g, S, E, tid);
        }
        SEAM(pb + 11);
    }
    if (IN(26)) { PH_IDS(); phase_final(in, args.out, ws, gw, NGW, lane); }
#undef IN
#undef SEAM
}

extern "C" void kernel_launch(void* const* d_in, const int* in_sizes, int n_in, void* d_out, int out_size, void* d_ws, size_t ws_size, hipStream_t stream) {
    static int grid = 0;
    if (grid == 0) {
        if (n_in != N_IN || in_sizes[0] != T_LAT * DM || out_size != T_LAT * DM || ws_size < WS_END) {
            fprintf(stderr, "kernel_launch: shape mismatch (n_in %d in0 %d out %d ws %zu, need ws >= %zu); nothing launched\n", n_in, n_in > 0 ? in_sizes[0] : -1, out_size, ws_size, (size_t)WS_END); grid = -1; return; }
        int dev = 0, cus = 0, per_cu = 0;
        if (hipGetDevice(&dev) != hipSuccess || hipDeviceGetAttribute(&cus, hipDeviceAttributeMultiprocessorCount, dev) != hipSuccess) { grid = -1; return; }
        if (hipFuncSetAttribute((const void*)fwd_kernel, hipFuncAttributeMaxDynamicSharedMemorySize, LDS_BYTES) != hipSuccess) { fprintf(stderr, "kernel_launch: hipFuncSetAttribute failed\n"); grid = -1; return; }
        if (hipOccupancyMaxActiveBlocksPerMultiprocessor(&per_cu, (const void*)fwd_kernel, NTHR, LDS_BYTES) != hipSuccess || per_cu < 1) fprintf(stderr, "kernel_launch: occupancy query says %d\n", per_cu);
        (void)hipGetLastError();
        if (cus < 256) { fprintf(stderr, "kernel_launch: %d CUs < 256; nothing launched\n", cus); grid = -1; return; }
        grid = 256;
    }
    if (grid < 0) return;
    (void)hipMemsetAsync((char*)d_ws + WS_CTL, 0, CTL_ZERO_BYTES, stream);
    Args a{};
    for (int i = 0; i < N_IN; ++i) a.in[i] = (const float*)d_in[i];
    a.out = (float*)d_out; a.ws = (unsigned char*)d_ws;
#if MK_PER_PHASE
    for (int p = 0; p < NPHASES; ++p) { a.ph_lo = p; a.ph_hi = p + 1; hipLaunchKernelGGL(fwd_kernel, dim3(grid), dim3(NTHR), LDS_BYTES, stream, a); }
#else
    a.ph_lo = 0; a.ph_hi = NPHASES; hipLaunchKernelGGL(fwd_kernel, dim3(grid), dim3(NTHR), LDS_BYTES, stream, a);
#endif
    const hipError_t le = hipPeekAtLastError();
    if (le != hipSuccess) fprintf(stderr, "kernel_launch: launch failed: %s\n", hipGetErrorName(le));
}
```
